# Optimizing an MI355X kernel written in HIP

```python
import math
import jax
import jax.numpy as jnp
from jax import lax
import numpy as np

D_MODEL = 1024
BATCH = 4
SEQ = 8192
DEPTH = 2
DEC_BATCH = 32
DEC_SEQ = 32
PAST_LEN = 4096

CHUNK = 64
BAND_CHUNKS = 8
ATT_WINDOW = BAND_CHUNKS * CHUNK
A_HEADS = 8
A_HEAD_DIM = D_MODEL // 16
A_WIDTH = A_HEADS * A_HEAD_DIM
REL_MAX = 128
N_REL = (CHUNK - 1) + REL_MAX + 1
B_HEADS = 8
B_HEAD_DIM = D_MODEL // 16
B_WIDTH = B_HEADS * B_HEAD_DIM
B_QKV = 3 * B_WIDTH
CONV_W = 4
GDN_CHUNK = 64
SPLIT_SIZES = (A_WIDTH, A_WIDTH, A_WIDTH, A_WIDTH, B_QKV, B_WIDTH, B_HEADS, B_HEADS, D_MODEL, D_MODEL)
IN_DIM = 4 * A_WIDTH + B_QKV + B_WIDTH + 2 * B_HEADS + 2 * D_MODEL
ALPHA = (2 * DEPTH) ** 0.25
BETA = (8 * DEPTH) ** -0.25
LN_EPS = 1e-5
NORM_EPS = 1e-6

kernel_name = 'hybrid_chunkband_gdn_streaming_step'


def layer_norm(x, g, b):
    xf = x.astype(jnp.float32)
    mu = jnp.mean(xf, axis=-1, keepdims=True)
    var = jnp.mean(jnp.square(xf - mu), axis=-1, keepdims=True)
    y = (xf - mu) * lax.rsqrt(var + LN_EPS) * g.astype(jnp.float32) + b.astype(jnp.float32)
    return y.astype(x.dtype)


def split_projection(p):
    cuts = np.cumsum(SPLIT_SIZES)[:-1].tolist()
    return jnp.split(p, cuts, axis=-1)


def l2_normalize(z):
    zf = z.astype(jnp.float32)
    return zf * lax.rsqrt(jnp.sum(zf * zf, axis=-1, keepdims=True) + NORM_EPS)


def band_attention(q, k, v, q_pos, k_pos, k_valid, rel_bias):
    s = jnp.einsum('bqhd,bkhd->bhqk', q, k).astype(jnp.float32) * (A_HEAD_DIM ** -0.5)
    rel = jnp.clip(q_pos[:, None] - k_pos[None, :], -(CHUNK - 1), REL_MAX) + (CHUNK - 1)
    s = s + rel_bias[:, rel].astype(jnp.float32)[None]
    s = jnp.where(k_valid[None, None, None, :], s, -1e30)
    p = jax.nn.softmax(s, axis=-1)
    return jnp.einsum('bhqk,bkhd->bqhd', p.astype(v.dtype), v)


def chunk_band_attention(q, k, v, rel_bias):
    bsz, t, h, d = q.shape
    n_chunks = t // CHUNK
    band = ATT_WINDOW + CHUNK
    pad = ((0, 0), (ATT_WINDOW, 0), (0, 0), (0, 0))
    kp = jnp.pad(k, pad)
    vp = jnp.pad(v, pad)
    q_blocks = jnp.moveaxis(q.reshape(bsz, n_chunks, CHUNK, h, d), 1, 0)
    k_offs = jnp.arange(band, dtype=jnp.int32)
    q_offs = jnp.arange(CHUNK, dtype=jnp.int32)

    def one_chunk(args):
        c, q_blk = args
        start = c * CHUNK
        k_blk = lax.dynamic_slice_in_dim(kp, start, band, axis=1)
        v_blk = lax.dynamic_slice_in_dim(vp, start, band, axis=1)
        k_pos = start - ATT_WINDOW + k_offs
        q_pos = start + q_offs
        return band_attention(q_blk, k_blk, v_blk, q_pos, k_pos, k_pos >= 0, rel_bias)

    o = lax.map(one_chunk, (jnp.arange(n_chunks, dtype=jnp.int32), q_blocks))
    return jnp.moveaxis(o, 0, 1).reshape(bsz, t, h, d)


def causal_conv(x_full, w, t):
    acc = x_full[:, 0:t] * w[0]
    for i in range(1, CONV_W):
        acc = acc + x_full[:, i:i + t] * w[i]
    return acc


def gated_delta_rule(q, k, v, g, beta, s0):
    f32 = jnp.float32
    bsz, t, h, dk = q.shape
    dv = v.shape[-1]
    blk = min(t, GDN_CHUNK)
    nb = t // blk

    def to_blocks(z):
        z = z.astype(f32).reshape((bsz, nb, blk, h) + z.shape[3:])
        return jnp.moveaxis(jnp.swapaxes(z, 2, 3), 1, 0)

    qb = to_blocks(q)
    kb = to_blocks(k)
    vb = to_blocks(v)
    gb = to_blocks(g)
    bb = to_blocks(beta)
    gc = jnp.cumsum(gb, axis=-1)
    causal = jnp.tril(jnp.ones((blk, blk), dtype=bool))
    strict = jnp.tril(jnp.ones((blk, blk), dtype=f32), -1)
    decay = jnp.exp(jnp.where(causal, gc[..., :, None] - gc[..., None, :], -jnp.inf))
    k_beta = kb * bb[..., None]
    v_beta = vb * bb[..., None]
    m = jnp.einsum('nbhid,nbhjd->nbhij', k_beta, kb) * decay * strict
    eye = jnp.eye(blk, dtype=f32)
    t_inv = lax.linalg.triangular_solve(eye + m, jnp.broadcast_to(eye, m.shape),
                                        left_side=True, lower=True, unit_diagonal=True)
    u = jnp.einsum('nbhij,nbhjd->nbhid', t_inv, v_beta)
    w = jnp.einsum('nbhij,nbhjd->nbhid', t_inv, k_beta * jnp.exp(gc)[..., None])
    qk = jnp.einsum('nbhid,nbhjd->nbhij', qb, kb) * decay

    def step(s, blk_in):
        q_c, k_c, u_c, w_c, gc_c, qk_c = blk_in
        v_new = u_c - jnp.einsum('bhld,bhde->bhle', w_c, s)
        o_c = (jnp.einsum('bhld,bhde->bhle', q_c * jnp.exp(gc_c)[..., None], s)
               + jnp.einsum('bhij,bhje->bhie', qk_c, v_new))
        g_last = gc_c[..., -1]
        k_dec = k_c * jnp.exp(g_last[..., None] - gc_c)[..., None]
        s = s * jnp.exp(g_last)[..., None, None] + jnp.einsum('bhld,bhle->bhde', k_dec, v_new)
        return s, o_c

    s_final, o = lax.scan(step, s0.astype(f32), (qb, kb, u, w, gc, qk))
    o = jnp.swapaxes(jnp.moveaxis(o, 0, 1), 2, 3).reshape(bsz, t, h, dv)
    return o, s_final


def trunk_layer(x, kv_past, conv_prev, s_prev, w_in, rel_bias, conv_w, a_log, dt_bias,
                gdn_norm_w, w_branch_a, w_branch_b, w_out, ln_g, ln_b):
    f32 = jnp.float32
    bsz, t, _ = x.shape
    qa, ka, va, za, qkv_b, zb, a_b, b_b, gate_a, gate_b = split_projection(x @ w_in)

    qa = qa.reshape(bsz, t, A_HEADS, A_HEAD_DIM)
    ka = ka.reshape(bsz, t, A_HEADS, A_HEAD_DIM)
    va = va.reshape(bsz, t, A_HEADS, A_HEAD_DIM)
    if kv_past is None:
        oa = chunk_band_attention(qa, ka, va, rel_bias)
        keep = min(ATT_WINDOW, t)
        new_k = ka[:, t - keep:]
        new_v = va[:, t - keep:]
    else:
        k_past, v_past = kv_past
        n_past = k_past.shape[1]
        k_all = jnp.concatenate([k_past.astype(ka.dtype), ka], axis=1)
        v_all = jnp.concatenate([v_past.astype(va.dtype), va], axis=1)
        q_pos = PAST_LEN + jnp.arange(t, dtype=jnp.int32)
        k_pos = PAST_LEN - n_past + jnp.arange(n_past + t, dtype=jnp.int32)
        oa = band_attention(qa, k_all, v_all, q_pos, k_pos, jnp.ones((n_past + t,), dtype=bool), rel_bias)
        new_k = ka
        new_v = va
    ya = (oa.reshape(bsz, t, A_WIDTH) * jax.nn.silu(za)) @ w_branch_a

    xp = jnp.concatenate([conv_prev.astype(qkv_b.dtype), qkv_b], axis=1)
    new_conv = xp[:, -(CONV_W - 1):]
    c = jax.nn.silu(causal_conv(xp, conv_w, t))
    qb, kb, vb = jnp.split(c, 3, axis=-1)
    qb = l2_normalize(qb.reshape(bsz, t, B_HEADS, B_HEAD_DIM)) * (B_HEAD_DIM ** -0.5)
    kb = l2_normalize(kb.reshape(bsz, t, B_HEADS, B_HEAD_DIM))
    vb = vb.reshape(bsz, t, B_HEADS, B_HEAD_DIM)
    g = -jnp.exp(a_log.astype(f32)) * jax.nn.softplus(a_b.astype(f32) + dt_bias.astype(f32))
    beta = jax.nn.sigmoid(b_b.astype(f32))
    ob, s_new = gated_delta_rule(qb, kb, vb, g, beta, s_prev)
    ob = ob * lax.rsqrt(jnp.mean(ob * ob, axis=-1, keepdims=True) + NORM_EPS) * gdn_norm_w.astype(f32)
    ob = ob.astype(x.dtype).reshape(bsz, t, B_WIDTH)
    yb = (ob * jax.nn.silu(zb)) @ w_branch_b

    mix = jax.nn.sigmoid(gate_a) * ya + jax.nn.sigmoid(gate_b) * yb
    y = layer_norm(ALPHA * x + mix @ w_out, ln_g, ln_b)
    return y, (new_k, new_v, new_conv, s_new.astype(x.dtype))


def setup_inputs(seed: int = 0) -> dict:
    key = jax.random.key(seed)
    ks = jax.random.split(key, 24)
    nrm = jax.random.normal
    n_cache = min(ATT_WINDOW, PAST_LEN)
    x_prompt = nrm(ks[0], (BATCH, SEQ, D_MODEL), jnp.float32)
    x_sample = nrm(ks[1], (DEC_BATCH, DEC_SEQ, D_MODEL), jnp.float32)
    cache_attn_k = nrm(ks[2], (DEPTH, DEC_BATCH, n_cache, A_HEADS, A_HEAD_DIM), jnp.float32)
    cache_attn_v = nrm(ks[3], (DEPTH, DEC_BATCH, n_cache, A_HEADS, A_HEAD_DIM), jnp.float32) * BETA
    state_conv = nrm(ks[4], (DEPTH, DEC_BATCH, CONV_W - 1, B_QKV), jnp.float32)
    state_gdn = nrm(ks[5], (DEPTH, DEC_BATCH, B_HEADS, B_HEAD_DIM, B_HEAD_DIM), jnp.float32) * 0.05
    ln0_g = 1.0 + 0.05 * nrm(ks[6], (D_MODEL,), jnp.float32)
    ln0_b = 0.02 * nrm(ks[7], (D_MODEL,), jnp.float32)
    col_scale = np.ones((IN_DIM,), np.float32)
    col_scale[2 * A_WIDTH:3 * A_WIDTH] = BETA
    v_off = 4 * A_WIDTH + 2 * B_WIDTH
    col_scale[v_off:v_off + B_WIDTH] = BETA
    w_in = nrm(ks[8], (DEPTH, D_MODEL, IN_DIM), jnp.float32) * (D_MODEL ** -0.5) * jnp.asarray(col_scale)
    rel_bias = 0.5 * nrm(ks[9], (DEPTH, A_HEADS, N_REL), jnp.float32)
    conv_w = nrm(ks[10], (DEPTH, CONV_W, B_QKV), jnp.float32) * (CONV_W ** -0.5)
    a_log = jnp.log(jax.random.uniform(ks[11], (DEPTH, B_HEADS), jnp.float32, 1.0, 16.0))
    dt = jnp.exp(jax.random.uniform(ks[12], (DEPTH, B_HEADS), jnp.float32, math.log(1e-3), math.log(1e-1)))
    dt_bias = dt + jnp.log(-jnp.expm1(-dt))
    gdn_norm_w = 1.0 + 0.05 * nrm(ks[13], (DEPTH, B_HEAD_DIM), jnp.float32)
    w_branch_a = nrm(ks[14], (DEPTH, A_WIDTH, D_MODEL), jnp.float32) * (A_WIDTH ** -0.5) * BETA
    w_branch_b = nrm(ks[15], (DEPTH, B_WIDTH, D_MODEL), jnp.float32) * (B_WIDTH ** -0.5) * BETA
    w_out = nrm(ks[16], (DEPTH, D_MODEL, D_MODEL), jnp.float32) * (D_MODEL ** -0.5) * BETA
    ln_g = 1.0 + 0.05 * nrm(ks[17], (DEPTH, D_MODEL), jnp.float32)
    ln_b = 0.02 * nrm(ks[18], (DEPTH, D_MODEL), jnp.float32)
    return {'x_prompt': x_prompt, 'x_sample': x_sample,
            'cache_attn_k': cache_attn_k, 'cache_attn_v': cache_attn_v,
            'state_conv': state_conv, 'state_gdn': state_gdn,
            'ln0_g': ln0_g, 'ln0_b': ln0_b, 'w_in': w_in, 'rel_bias': rel_bias,
            'conv_w': conv_w, 'a_log': a_log, 'dt_bias': dt_bias, 'gdn_norm_w': gdn_norm_w,
            'w_branch_a': w_branch_a, 'w_branch_b': w_branch_b, 'w_out': w_out,
            'ln_g': ln_g, 'ln_b': ln_b}


def reference(x_prompt, x_sample, cache_attn_k, cache_attn_v, state_conv, state_gdn,
              ln0_g, ln0_b, w_in, rel_bias, conv_w, a_log, dt_bias, gdn_norm_w,
              w_branch_a, w_branch_b, w_out, ln_g, ln_b):
    hp = layer_norm(x_prompt, ln0_g, ln0_b)
    hs = layer_norm(x_sample, ln0_g, ln0_b)
    n_prompt = x_prompt.shape[0]
    conv_zero = jnp.zeros((n_prompt, CONV_W - 1, B_QKV), x_prompt.dtype)
    s_zero = jnp.zeros((n_prompt, B_HEADS, B_HEAD_DIM, B_HEAD_DIM), jnp.float32)
    kp_list = []
    vp_list = []
    cp_list = []
    sp_list = []
    ks_list = []
    vs_list = []
    cs_list = []
    ss_list = []
    for l in range(DEPTH):
        params = (w_in[l], rel_bias[l], conv_w[l], a_log[l], dt_bias[l], gdn_norm_w[l],
                  w_branch_a[l], w_branch_b[l], w_out[l], ln_g[l], ln_b[l])
        hp, (k_p, v_p, c_p, s_p) = trunk_layer(hp, None, conv_zero, s_zero, *params)
        hs, (k_s, v_s, c_s, s_s) = trunk_layer(hs, (cache_attn_k[l], cache_attn_v[l]),
                                               state_conv[l], state_gdn[l], *params)
        kp_list.append(k_p)
        vp_list.append(v_p)
        cp_list.append(c_p)
        sp_list.append(s_p)
        ks_list.append(k_s)
        vs_list.append(v_s)
        cs_list.append(c_s)
        ss_list.append(s_s)
    return (hp, hs,
            jnp.stack(kp_list), jnp.stack(vp_list), jnp.stack(cp_list), jnp.stack(sp_list),
            jnp.stack(ks_list), jnp.stack(vs_list), jnp.stack(cs_list), jnp.stack(ss_list))
```

```cpp
#include <hip/hip_runtime.h>
#include <cstdio>
#include <cstdint>

#ifndef MK_PER_PHASE
#define MK_PER_PHASE 1
#endif

constexpr int D = 1024, BATCH = 4, SEQ = 8192, DEPTH = 2, DECB = 32, DECS = 32, PAST = 4096;
constexpr int MP = BATCH * SEQ, MS = DECB * DECS, M = MP + MS;
constexpr int CHUNK = 64, ATTW = 512, AH = 8, AD = 64, AW = 512, NREL = 192, RELMAX = 128;
constexpr int BH = 8, BD = 64, BW = 512, BQKV = 1536;
constexpr int IN_DIM = 6160, NIN = 6400;
constexpr float LN_EPS = 1e-5f, NORM_EPS = 1e-6f;
constexpr float ALPHA = 1.41421356237309515f;
constexpr float LOG2E = 1.4426950408889634f;
constexpr float QSCALE = 0.125f * LOG2E;

constexpr size_t O_Y = 0;
constexpr size_t O_KP = (size_t)M * D;
constexpr size_t O_VP = O_KP + (size_t)DEPTH * BATCH * ATTW * AW;
constexpr size_t O_CP = O_VP + (size_t)DEPTH * BATCH * ATTW * AW;
constexpr size_t O_GP = O_CP + (size_t)DEPTH * BATCH * 3 * BQKV;
constexpr size_t O_KS = O_GP + (size_t)DEPTH * BATCH * BH * BD * BD;
constexpr size_t O_VS = O_KS + (size_t)DEPTH * DECB * DECS * AW;
constexpr size_t O_CS = O_VS + (size_t)DEPTH * DECB * DECS * AW;
constexpr size_t O_GS = O_CS + (size_t)DEPTH * DECB * 3 * BQKV;
constexpr size_t O_END = O_GS + (size_t)DEPTH * DECB * BH * BD * BD;
static_assert(O_END == 43585536, "output size");

constexpr size_t MiB = 1u << 20;
constexpr size_t WS_CTL = 0, CTL_ZERO_BYTES = 1 * MiB;
constexpr size_t WS_WIN = 1 * MiB;
constexpr size_t WS_WAB = 26 * MiB;
constexpr size_t WS_WO = 30 * MiB;
constexpr size_t WS_G = 34 * MiB;
constexpr size_t WS_BETA = WS_G + (size_t)M * 8 * 4;
constexpr size_t WS_HB = 37 * MiB;
constexpr size_t WS_KA = 103 * MiB, WS_VA = 136 * MiB, WS_SZA = 169 * MiB;
constexpr size_t WS_OAB = 202 * MiB;
constexpr size_t WS_XB = 268 * MiB;
constexpr size_t WS_GA = 367 * MiB, WS_GB = 433 * MiB;
constexpr size_t WS_END = 499 * MiB;
constexpr size_t WS_MIX = WS_HB;
constexpr size_t WS_Z = WS_GA;
static_assert(WS_BETA + (size_t)M * 8 * 4 <= WS_HB && WS_HB + (size_t)M * D * 2 <= WS_KA && WS_SZA + (size_t)M * 512 * 2 <= WS_OAB, "ws map");
static_assert(WS_OAB + (size_t)M * D * 2 <= WS_XB && WS_XB + (size_t)M * BQKV * 2 <= WS_GA && WS_GB + (size_t)M * D * 2 <= WS_END, "ws map 2");
static_assert(WS_Z + (size_t)M * D * 4 <= WS_END, "ws map 3");
constexpr int CW_TMO = 0, CW_CODE = 1, CW_BAR = 4096;

constexpr int RING_OFF = 0, RING_BYTES = 131072;
constexpr int LDSCTL_OFF = RING_BYTES, MISC_OFF = LDSCTL_OFF + 320;
constexpr int BIAS_OFF = RING_BYTES + 1024;
constexpr int LDS_BYTES = 147456;
static_assert(BIAS_OFF + AH * NREL * 4 <= LDS_BYTES && MISC_OFF + 128 <= BIAS_OFF, "LDS map");
constexpr int NWAVES = 8;

namespace pg8 {
#define PG8_LAS __attribute__((address_space(3)))
typedef unsigned short bf16_t;
typedef short bf16x8 __attribute__((ext_vector_type(8)));
typedef float f32x4 __attribute__((ext_vector_type(4)));
typedef unsigned u32x4 __attribute__((ext_vector_type(4)));
constexpr int BM = 256, BK = 64, HALF = 128, HTB = HALF * BK * 2  , STAGE_BYTES = 8 * HTB, NXCD = 8, WGM = 8;

__host__ __device__ __forceinline__ int lds_byte(int r, int c) { const int st = (r >> 4) * 2 + (c >> 5), rr = r & 15, cc = c & 31, ob = rr * 64 + cc * 2; return st * 1024 + (ob ^ (((ob >> 9) & 1) << 5)); }
__host__ __device__ __forceinline__ void stage_rc(int b, int& R, int& C) { const int st = b / 1024, sb = b % 1024, swz = sb ^ (((sb >> 9) & 1) << 5); R = (st >> 1) * 16 + swz / 64; C = (st & 1) * 32 + (swz % 64) / 2; }
__host__ __device__ __forceinline__ int perm32(int rho) { const int n = rho >> 4, i = rho & 15; return 8 * (i >> 2) + 4 * n + (i & 3); }

struct Unit { int pm, pn; };
struct Gemm { const bf16_t* A; const bf16_t* Bt; int M, N, K; };

struct StaticOrder {
    int nM, nN, nwg, G, c;
    __host__ __device__ void init(int M, int N, int G_, int c_) { nM = M / BM; nN = N / BM; nwg = nM * nN; G = G_; c = c_; }
    __host__ __device__ bool next(int i, Unit& u) const {
        const long L = (long)i * G + c; if (L >= nwg) return false;
        int wgid = (int)L; { const int q = nwg / NXCD, r = nwg % NXCD, xcd = wgid % NXCD, off = wgid / NXCD; wgid = (xcd < r ? xcd * (q + 1) : r * (q + 1) + (xcd - r) * q) + off; }
        const int nig = WGM * nN, gid = wgid / nig, fm = gid * WGM, gsz = (nM - fm) < WGM ? (nM - fm) : WGM;
        u.pm = fm + ((wgid % nig) % gsz); u.pn = (wgid % nig) / gsz; return true;
    }
    __device__ __forceinline__ void a_ready(const Unit&) const {}
    __device__ __forceinline__ void done(const Unit&) const {}
};


__device__ __forceinline__ unsigned cvt_pk_bf16(float lo, float hi) { unsigned r; asm volatile("v_cvt_pk_bf16_f32 %0, %1, %2" : "=v"(r) : "v"(lo), "v"(hi)); return r; }
__device__ __forceinline__ float bf_lo(unsigned w) { return __uint_as_float(w << 16); }
__device__ __forceinline__ float bf_hi(unsigned w) { return __uint_as_float(w & 0xffff0000u); }
__device__ __forceinline__ float sigmoid_f(float x) { return __builtin_amdgcn_rcpf(1.0f + __expf(-x)); }
__device__ __forceinline__ float silu_f(float x) { return x * sigmoid_f(x); }
__device__ __forceinline__ u32x4 pack8(const f32x4& a, const f32x4& b) { u32x4 w; w.x = cvt_pk_bf16(a[0], a[1]); w.y = cvt_pk_bf16(a[2], a[3]); w.z = cvt_pk_bf16(b[0], b[1]); w.w = cvt_pk_bf16(b[2], b[3]); return w; }

template <int ACT  > __device__ __forceinline__ void epi_store_bf16(const f32x4 (&acc)[2][2][4][2], unsigned char* base, unsigned off0, unsigned ldb  , float scale) {
#pragma unroll
    for (int ai = 0; ai < 2; ++ai)
#pragma unroll
        for (int m = 0; m < 4; ++m) {
#pragma unroll
            for (int bj = 0; bj < 2; ++bj) {
                f32x4 v0 = acc[ai][bj][m][0], v1 = acc[ai][bj][m][1];
                if (ACT == 0) { v0 = v0 * scale; v1 = v1 * scale; }
                if (ACT == 1) {
#pragma unroll
                    for (int j = 0; j < 4; ++j) { v0[j] = silu_f(v0[j]); v1[j] = silu_f(v1[j]); } }
                if (ACT == 2) {
#pragma unroll
                    for (int j = 0; j < 4; ++j) { v0[j] = sigmoid_f(v0[j]); v1[j] = sigmoid_f(v1[j]); } }
                *(u32x4*)(base + (off0 + (unsigned)(ai * HALF + m * 16) * ldb + (unsigned)(bj * HALF * 2))) = pack8(v0, v1);
            }
            asm volatile("" ::: "memory");
        }
}
__device__ __forceinline__ void epi_store_f32_rows(const f32x4 (&acc)[2][2][4][2], unsigned char* base, unsigned off0, unsigned ldb, int rt0, int r_lo, int r_hi) {
#pragma unroll
    for (int ai = 0; ai < 2; ++ai)
#pragma unroll
        for (int m = 0; m < 4; ++m) {
            const int rt = rt0 + ai * HALF + m * 16;
            if (rt >= r_lo && rt < r_hi) {
#pragma unroll
                for (int bj = 0; bj < 2; ++bj) {
                    unsigned char* p = base + (off0 + (unsigned)(ai * HALF + m * 16) * ldb + (unsigned)(bj * HALF * 4));
                    *(f32x4*)p = acc[ai][bj][m][0]; *(f32x4*)(p + 16) = acc[ai][bj][m][1];
                }
            }
            asm volatile("" ::: "memory");
        }
}
struct EpiInProj {
    static constexpr bool PERM = true, AFTER_DRAIN = false; static constexpr int MIDK = 0;
    unsigned char* ws; float* out; const float* a_log; const float* dt_bias; int l;
    __device__ __forceinline__ void operator()(const f32x4 (&acc)[2][2][4][2], const Unit& u, int wr, int wc, int fr, int fq) const {
        const int pn = u.pn, pm = u.pm;
        const int rt0 = wr * 64 + fr;
        const int ct0 = wc * 32 + 8 * fq;
        const unsigned row0 = (unsigned)pm * BM + rt0;
        if (pn < 2) {
            epi_store_bf16<0>(acc, ws + WS_OAB, (row0 * 1024u + pn * 256 + ct0) * 2u, 2048u, QSCALE);
        } else if (pn < 6) {
            const int isv = (pn >= 4); const unsigned col = (unsigned)(pn - (isv ? 4 : 2)) * 256 + ct0;
            epi_store_bf16<0>(acc, ws + (isv ? WS_VA : WS_KA), (row0 * 512u + col) * 2u, 1024u, 1.0f);
            if (pm >= 128) {
                unsigned char* ob = (unsigned char*)(out + (isv ? O_VS : O_KS) + (size_t)l * DECB * DECS * AW);
                epi_store_f32_rows(acc, ob, ((row0 - MP) * 512u + col) * 4u, 2048u, rt0, 0, 256);
            } else if ((pm & 31) >= 30) {
                unsigned char* ob = (unsigned char*)(out + (isv ? O_VP : O_KP) + (size_t)l * BATCH * ATTW * AW);
                epi_store_f32_rows(acc, ob, ((((unsigned)(pm >> 5) * ATTW + ((pm & 31) - 30) * 256 + rt0) * 512u) + col) * 4u, 2048u, rt0, 0, 256);
            }
        } else if (pn < 8) {
            epi_store_bf16<1>(acc, ws + WS_SZA, (row0 * 512u + (pn - 6) * 256 + ct0) * 2u, 1024u, 1.0f);
        } else if (pn < 14) {
            const unsigned col = (unsigned)(pn - 8) * 256 + ct0;
            epi_store_bf16<0>(acc, ws + WS_XB, (row0 * (unsigned)BQKV + col) * 2u, BQKV * 2u, 1.0f);
            if (pm >= 128) {
                float* oCs = out + O_CS + (size_t)l * DECB * 3 * BQKV;
#pragma unroll
                for (int ai = 0; ai < 2; ++ai)
#pragma unroll
                    for (int m = 0; m < 4; ++m) { const int rs = (int)(row0 - MP) + ai * HALF + m * 16, t = rs & 31;
                        if (t >= 29) {
#pragma unroll
                            for (int bj = 0; bj < 2; ++bj) { float* o = oCs + ((size_t)(rs >> 5) * 3 + (t - 29)) * BQKV + col + bj * HALF; *(f32x4*)o = acc[ai][bj][m][0]; *(f32x4*)(o + 4) = acc[ai][bj][m][1]; } }
                        asm volatile("" ::: "memory"); }
            } else if ((pm & 31) == 31) {
                unsigned char* ob = (unsigned char*)(out + O_CP + (size_t)l * BATCH * 3 * BQKV);
                epi_store_f32_rows(acc, ob, ((((unsigned)(pm >> 5) * 3 + (unsigned)(rt0 - 253)) * BQKV) + col) * 4u, BQKV * 4u, rt0, 253, 256);
            }
        } else if (pn < 16) {
            epi_store_bf16<1>(acc, ws + WS_OAB, (row0 * 1024u + 512 + (pn - 14) * 256 + ct0) * 2u, 2048u, 1.0f);
        } else if (pn < 24) {
            epi_store_bf16<2>(acc, ws + (pn < 20 ? WS_GA : WS_GB), (row0 * 1024u + ((pn - 16) & 3) * 256 + ct0) * 2u, 2048u, 1.0f);
        } else {
            if (wc == 0 && fq < 2) {
                float* G = (float*)(ws + WS_G); float* BETA = (float*)(ws + WS_BETA);
#pragma unroll
                for (int ai = 0; ai < 2; ++ai)
#pragma unroll
                    for (int m = 0; m < 4; ++m) {
                        const size_t row = (size_t)row0 + ai * HALF + m * 16;
                        f32x4 v0 = acc[ai][0][m][0], v1 = acc[ai][0][m][1];
                        float* dst = (fq == 0 ? G : BETA) + row * 8;
                        *(f32x4*)dst = v0; *(f32x4*)(dst + 4) = v1;
                        asm volatile("" ::: "memory");
                    }
            }
        }
    }
};

struct EpiMix {
    static constexpr bool PERM = true, AFTER_DRAIN = false; static constexpr int MIDK = 8;
    unsigned char* ws;
    __device__ __forceinline__ void mid(f32x4 (&acc)[2][2][4][2], const Unit& u, int wr, int wc, int fr, int fq) const {
        unsigned off0 = (((unsigned)u.pm * BM + wr * 64 + fr) * 1024u + u.pn * BM + wc * 32 + 8 * fq) * 2u;
        asm volatile("" : "+v"(off0));
        const unsigned char* GA = ws + WS_GA; const unsigned char* GB = ws + WS_GB;
#pragma unroll
        for (int ai = 0; ai < 2; ++ai)
#pragma unroll
            for (int m = 0; m < 4; ++m) {
#pragma unroll
                for (int bj = 0; bj < 2; ++bj) {
                    const unsigned off = off0 + (unsigned)(ai * HALF + m * 16) * 2048u + (unsigned)(bj * HALF * 2);
                    const u32x4 a = *(const u32x4*)(GA + off), b = *(const u32x4*)(GB + off);
                    f32x4 r0, r1;
                    r0[0] = bf_lo(a.x) * __builtin_amdgcn_rcpf(bf_lo(b.x)); r0[1] = bf_hi(a.x) * __builtin_amdgcn_rcpf(bf_hi(b.x));
                    r0[2] = bf_lo(a.y) * __builtin_amdgcn_rcpf(bf_lo(b.y)); r0[3] = bf_hi(a.y) * __builtin_amdgcn_rcpf(bf_hi(b.y));
                    r1[0] = bf_lo(a.z) * __builtin_amdgcn_rcpf(bf_lo(b.z)); r1[1] = bf_hi(a.z) * __builtin_amdgcn_rcpf(bf_hi(b.z));
                    r1[2] = bf_lo(a.w) * __builtin_amdgcn_rcpf(bf_lo(b.w)); r1[3] = bf_hi(a.w) * __builtin_amdgcn_rcpf(bf_hi(b.w));
                    acc[ai][bj][m][0] = acc[ai][bj][m][0] * r0; acc[ai][bj][m][1] = acc[ai][bj][m][1] * r1;
                }
                asm volatile("" ::: "memory");
            }
    }
    __device__ __forceinline__ void operator()(const f32x4 (&acc)[2][2][4][2], const Unit& u, int wr, int wc, int fr, int fq) const {
        const unsigned off0 = (((unsigned)u.pm * BM + wr * 64 + fr) * 1024u + u.pn * BM + wc * 32 + 8 * fq) * 2u;
        const unsigned char* GB = ws + WS_GB; unsigned char* MIX = ws + WS_MIX;
#pragma unroll
        for (int ai = 0; ai < 2; ++ai)
#pragma unroll
            for (int m = 0; m < 4; ++m) {
#pragma unroll
                for (int bj = 0; bj < 2; ++bj) {
                    const unsigned off = off0 + (unsigned)(ai * HALF + m * 16) * 2048u + (unsigned)(bj * HALF * 2);
                    const u32x4 b = *(const u32x4*)(GB + off);
                    f32x4 v0 = acc[ai][bj][m][0], v1 = acc[ai][bj][m][1];
                    v0[0] *= bf_lo(b.x); v0[1] *= bf_hi(b.x); v0[2] *= bf_lo(b.y); v0[3] *= bf_hi(b.y);
                    v1[0] *= bf_lo(b.z); v1[1] *= bf_hi(b.z); v1[2] *= bf_lo(b.w); v1[3] *= bf_hi(b.w);
                    *(u32x4*)(MIX + off) = pack8(v0, v1);
                }
                asm volatile("" ::: "memory");
            }
    }
};

struct EpiResid {
    static constexpr bool PERM = false, AFTER_DRAIN = false; static constexpr int MIDK = 0;
    const float* H; float* Z;
    __device__ __forceinline__ void operator()(const f32x4 (&acc)[2][2][4][2], const Unit& u, int wr, int wc, int fr, int fq) const {
        const int row0 = u.pm * BM + wr * 64 + fr, col0 = u.pn * BM + wc * 32 + 4 * fq;
#pragma unroll
        for (int ai = 0; ai < 2; ++ai)
#pragma unroll
            for (int m = 0; m < 4; ++m) { const size_t off = (size_t)(row0 + ai * HALF + m * 16) * D + col0;
#pragma unroll
                for (int bj = 0; bj < 2; ++bj)
#pragma unroll
                    for (int n = 0; n < 2; ++n) { const f32x4 h = *(const f32x4*)(H + off + bj * HALF + n * 16); *(f32x4*)(Z + off + bj * HALF + n * 16) = h * ALPHA + acc[ai][bj][m][n]; } }
    }
};

template <class Epi, class Sched, bool ALIGN_EPI = false, bool SP2 = false>
__device__ __forceinline__ void gemm_phase(PG8_LAS unsigned char* lds, const Gemm g, const Sched& S, const Epi& E) {
    const int tid = threadIdx.x, wid = __builtin_amdgcn_readfirstlane(tid >> 6), lane = tid & 63, wr = wid >> 2, wc = wid & 3, fr = lane & 15, fq = lane >> 4;
    const int K = g.K, nt = K / BK;
    unsigned voffA[2], voffB[2];
#pragma unroll
    for (int i = 0; i < 2; ++i) { int R, C; stage_rc(tid * 16 + i * 8192, R, C); const int Rb = Epi::PERM ? ((R & ~31) + perm32(R & 31)) : R;
        voffA[i] = (unsigned)(R * K + C) * 2u; voffB[i] = (unsigned)(Rb * K + C) * 2u; }
    const size_t kstep = (size_t)(BK * 2);
    const size_t hstep = (size_t)HALF * K * 2;
    const size_t tstep = 2 * hstep;
    const unsigned ldsw = (unsigned)wid * 1024u;
    const int aoff = lds_byte(wr * 64 + fr, fq * 8), boff = lds_byte(wc * 32 + fr, fq * 8);
#define PG8_SA(b, h) (((b) * 2 + (h)) * HTB)
#define PG8_SB(b, h) ((4 + (b) * 2 + (h)) * HTB)
#define PG8_STAGE(bufoff, gbase, voff) do { _Pragma("unroll") for (int _i = 0; _i < 2; ++_i) \
        __builtin_amdgcn_global_load_lds((const unsigned*)((const char*)(gbase) + (voff)[_i]), (PG8_LAS unsigned*)(lds + (bufoff) + ldsw + _i * 8192), 16, 0, 0); } while (0)
#define PG8_LDA(dst, b, h) do { _Pragma("unroll") for (int m = 0; m < 4; ++m) _Pragma("unroll") for (int k = 0; k < 2; ++k) dst[m][k] = *(const PG8_LAS bf16x8*)(lds + PG8_SA(b, h) + aoff + m * 2048 + k * 1024); } while (0)
#define PG8_LDB(dst, b, h) do { _Pragma("unroll") for (int n = 0; n < 2; ++n) _Pragma("unroll") for (int k = 0; k < 2; ++k) dst[n][k] = *(const PG8_LAS bf16x8*)(lds + PG8_SB(b, h) + boff + n * 2048 + k * 1024); } while (0)
#define PG8_MMA(ai, bj, At, Bt) do { __builtin_amdgcn_s_setprio(1); _Pragma("unroll") for (int m = 0; m < 4; ++m) _Pragma("unroll") for (int n = 0; n < 2; ++n) _Pragma("unroll") for (int k = 0; k < 2; ++k) \
        acc[ai][bj][m][n] = __builtin_amdgcn_mfma_f32_16x16x32_bf16(Bt[n][k], At[m][k], acc[ai][bj][m][n], 0, 0, 0); __builtin_amdgcn_s_setprio(0); } while (0)
#define PG8_WAIT_V(n) asm volatile("s_waitcnt vmcnt(" #n ")" ::: "memory")
#define PG8_WAIT_L(n) asm volatile("s_waitcnt lgkmcnt(" #n ")" ::: "memory")
#define PG8_BAR __builtin_amdgcn_s_barrier()
#define PG8_SCHED __builtin_amdgcn_sched_barrier(0)
    Unit cur, nxt; int ui = 0;
    if (!S.next(0, cur)) return;
    f32x4 acc[2][2][4][2];
#pragma unroll
    for (int a = 0; a < 2; ++a)
#pragma unroll
        for (int b = 0; b < 2; ++b)
#pragma unroll
            for (int m = 0; m < 4; ++m)
#pragma unroll
                for (int n = 0; n < 2; ++n) acc[a][b][m][n] = (f32x4){0.f, 0.f, 0.f, 0.f};
    bf16x8 At[4][2], B0[2][2], B1[2][2];
    const char* cA = (const char*)g.A + (size_t)cur.pm * tstep; const char* cB = (const char*)g.Bt + (size_t)cur.pn * tstep;
    S.a_ready(cur);
    if constexpr (SP2) {
        PG8_STAGE(PG8_SB(0, 0), cB, voffB); PG8_STAGE(PG8_SB(0, 1), cB + hstep, voffB); PG8_STAGE(PG8_SA(0, 0), cA, voffA); PG8_STAGE(PG8_SA(0, 1), cA + hstep, voffA);
        if (wr == 1) PG8_BAR;
        PG8_WAIT_V(2); PG8_BAR;
        PG8_STAGE(PG8_SB(1, 0), cB + kstep, voffB); PG8_STAGE(PG8_SA(1, 0), cA + kstep, voffA); PG8_STAGE(PG8_SB(1, 1), cB + hstep + kstep, voffB);
        PG8_WAIT_V(6); PG8_BAR;
    } else {
        PG8_STAGE(PG8_SB(0, 0), cB, voffB); PG8_STAGE(PG8_SA(0, 0), cA, voffA); PG8_STAGE(PG8_SB(0, 1), cB + hstep, voffB); PG8_STAGE(PG8_SA(0, 1), cA + hstep, voffA);
        if (wr == 1) PG8_BAR;
        PG8_WAIT_V(4); PG8_BAR;
        PG8_STAGE(PG8_SB(1, 0), cB + kstep, voffB); PG8_STAGE(PG8_SA(1, 0), cA + kstep, voffA); PG8_STAGE(PG8_SB(1, 1), cB + hstep + kstep, voffB);
        PG8_WAIT_V(6); PG8_BAR;
    }
    for (;;) {
        const bool has_next = S.next(ui + 1, nxt);
        const char* nA = has_next ? (const char*)g.A + (size_t)nxt.pm * tstep : cA; const char* nB = has_next ? (const char*)g.Bt + (size_t)nxt.pn * tstep : cB;
        for (int t = 0; t < nt; t += 2) {
            if constexpr (Epi::MIDK > 0) { if (t == Epi::MIDK) E.mid(acc, cur, wr, wc, fr, fq); }
            const bool last = (t == nt - 2);
            const char* a1 = cA + (size_t)(t + 1) * kstep;
            const char* a2 = last ? nA : cA + (size_t)(t + 2) * kstep; const char* b2 = last ? nB : cB + (size_t)(t + 2) * kstep;
            const char* a3 = a2 + kstep; const char* b3 = b2 + kstep;
            if (last && has_next) S.a_ready(nxt);
            if constexpr (SP2) {
            PG8_LDB(B0, 0, 0); PG8_LDB(B1, 0, 1); PG8_SCHED; PG8_LDA(At, 0, 0); PG8_STAGE(PG8_SA(1, 1), a1 + hstep, voffA);
            PG8_WAIT_V(8); PG8_WAIT_L(0); PG8_BAR; PG8_MMA(0, 0, At, B0); PG8_MMA(0, 1, At, B1); PG8_BAR; PG8_SCHED;
            PG8_LDA(At, 0, 1); PG8_STAGE(PG8_SB(0, 0), b2, voffB); PG8_STAGE(PG8_SB(0, 1), b2 + hstep, voffB); PG8_STAGE(PG8_SA(0, 0), a2, voffA);
            PG8_WAIT_V(8); PG8_WAIT_L(0); PG8_BAR; PG8_MMA(1, 0, At, B0); PG8_MMA(1, 1, At, B1); PG8_BAR; PG8_SCHED;
            PG8_LDB(B0, 1, 0); PG8_LDB(B1, 1, 1); PG8_SCHED; PG8_LDA(At, 1, 0); PG8_STAGE(PG8_SA(0, 1), a2 + hstep, voffA);
            PG8_WAIT_V(8); PG8_WAIT_L(0); PG8_BAR; PG8_MMA(0, 0, At, B0); PG8_MMA(0, 1, At, B1); PG8_BAR; PG8_SCHED;
            PG8_LDA(At, 1, 1); PG8_STAGE(PG8_SB(1, 0), b3, voffB); PG8_STAGE(PG8_SB(1, 1), b3 + hstep, voffB); PG8_STAGE(PG8_SA(1, 0), a3, voffA);
            PG8_WAIT_V(8); PG8_WAIT_L(0); PG8_BAR; PG8_MMA(1, 0, At, B0); PG8_MMA(1, 1, At, B1); PG8_BAR; PG8_SCHED;
            } else {
            PG8_LDB(B0, 0, 0); PG8_SCHED; PG8_LDA(At, 0, 0); PG8_STAGE(PG8_SA(1, 1), a1 + hstep, voffA);
            PG8_WAIT_L(8); PG8_BAR; PG8_WAIT_L(0); PG8_MMA(0, 0, At, B0); PG8_BAR; PG8_SCHED;
            PG8_LDB(B1, 0, 1); PG8_STAGE(PG8_SB(0, 0), b2, voffB);
            PG8_BAR; PG8_WAIT_L(0); PG8_MMA(0, 1, At, B1); PG8_BAR;
            PG8_LDA(At, 0, 1); PG8_STAGE(PG8_SA(0, 0), a2, voffA);
            PG8_BAR; PG8_WAIT_L(0); PG8_MMA(1, 0, At, B0); PG8_BAR; PG8_SCHED;
            PG8_STAGE(PG8_SB(0, 1), b2 + hstep, voffB);
            PG8_WAIT_V(6); PG8_BAR; PG8_MMA(1, 1, At, B1); PG8_BAR;
            PG8_LDB(B0, 1, 0); PG8_SCHED; PG8_LDA(At, 1, 0); PG8_STAGE(PG8_SA(0, 1), a2 + hstep, voffA);
            PG8_WAIT_L(8); PG8_BAR; PG8_WAIT_L(0); PG8_MMA(0, 0, At, B0); PG8_BAR; PG8_SCHED;
            PG8_LDB(B1, 1, 1); PG8_STAGE(PG8_SB(1, 0), b3, voffB);
            PG8_BAR; PG8_WAIT_L(0); PG8_MMA(0, 1, At, B1); PG8_BAR;
            PG8_LDA(At, 1, 1); PG8_STAGE(PG8_SA(1, 0), a3, voffA);
            PG8_BAR; PG8_WAIT_L(0); PG8_MMA(1, 0, At, B0); PG8_BAR; PG8_SCHED;
            PG8_STAGE(PG8_SB(1, 1), b3 + hstep, voffB);
            PG8_WAIT_V(6); PG8_BAR; PG8_MMA(1, 1, At, B1); PG8_BAR;
            }
        }
        if constexpr (ALIGN_EPI) { if (wr == 0) PG8_BAR; }
        if constexpr (!Epi::AFTER_DRAIN) { E(acc, cur, wr, wc, fr, fq); S.done(cur); }
        if (!has_next) break;
#pragma unroll
        for (int a = 0; a < 2; ++a)
#pragma unroll
            for (int b = 0; b < 2; ++b)
#pragma unroll
                for (int m = 0; m < 4; ++m)
#pragma unroll
                    for (int n = 0; n < 2; ++n) acc[a][b][m][n] = (f32x4){0.f, 0.f, 0.f, 0.f};
        cur = nxt; cA = nA; cB = nB; ++ui;
        if constexpr (ALIGN_EPI) { if (wr == 1) PG8_BAR; }
    }
    PG8_WAIT_V(0);
    if constexpr (!ALIGN_EPI) { if (wr == 0) PG8_BAR; }
    PG8_BAR;
    if constexpr (Epi::AFTER_DRAIN) { E.fused(acc, cur, wr, wc, fr, fq, lds, wid, lane); S.done(cur); }
#undef PG8_SA
#undef PG8_SB
#undef PG8_STAGE
#undef PG8_LDA
#undef PG8_LDB
#undef PG8_MMA
#undef PG8_WAIT_V
#undef PG8_WAIT_L
#undef PG8_BAR
#undef PG8_SCHED
}
}
#define GAS __attribute__((address_space(1)))
#define LAS __attribute__((address_space(3)))
typedef unsigned short bf16;
typedef unsigned v4u __attribute__((ext_vector_type(4)));
typedef float f32x4 __attribute__((ext_vector_type(4)));
typedef short bf16x8 __attribute__((ext_vector_type(8)));
typedef GAS unsigned gu32;
typedef GAS unsigned long long gu64;
#define RLX_AGENT __ATOMIC_RELAXED, __HIP_MEMORY_SCOPE_AGENT
#define LDS_WAIT() asm volatile("s_waitcnt lgkmcnt(0)" ::: "memory")
#define VM_WAIT() asm volatile("s_waitcnt vmcnt(0)" ::: "memory")
__device__ __forceinline__ unsigned long long rt() { return __builtin_amdgcn_s_memrealtime(); }
__device__ __forceinline__ unsigned f2bf(float f) { unsigned u = __builtin_bit_cast(unsigned, f); return (u + 0x7fffu + ((u >> 16) & 1u)) >> 16; }
__device__ __forceinline__ unsigned pk2(float lo, float hi) { return f2bf(lo) | (f2bf(hi) << 16); }

#define XB_TMO      128
#define XB_XCNT(j)  (256  + 64 * (j))
#define XB_XSUB(j)  (1280 + 64 * (j))
#define XB_XGEN(j)  (2304 + 64 * (j))
#define XB_TOP      3328
#define XB_TOPGEN   3392
#define XCD_BAR_WORDS 3456
#define XB_SPIN_CAP (1u << 18)

__device__ __forceinline__ unsigned xb_ld(unsigned* p)              { return __hip_atomic_load(p, __ATOMIC_RELAXED, __HIP_MEMORY_SCOPE_AGENT); }
__device__ __forceinline__ unsigned xb_add(unsigned* p, unsigned v) { return __hip_atomic_fetch_add(p, v, __ATOMIC_RELAXED, __HIP_MEMORY_SCOPE_AGENT); }
__device__ __forceinline__ unsigned xb_xcc_id() { return (unsigned)__builtin_amdgcn_s_getreg((3 << 11) | 20) & 0xFu; }
#define XB_SPIN(cond, bar) do { unsigned _sp = 0; while (cond) { __builtin_amdgcn_s_sleep(1); \
    if ((++_sp & 255u) == 0u) { if (xb_ld(&(bar)[XB_TMO])) break; if (_sp > XB_SPIN_CAP) { atomicAdd(&(bar)[XB_TMO], 1u); break; } } } } while (0)

struct XcdBarrier {
    unsigned* bar; unsigned x;
    volatile LAS unsigned* st;
};

__device__ __forceinline__ XcdBarrier xcd_barrier_post(unsigned* bar, volatile LAS unsigned* st) {
    XcdBarrier b; b.bar = bar; b.x = xb_xcc_id(); b.st = st;
    if (threadIdx.x == 0) (void)xb_add(&bar[XB_XCNT(b.x)], 1u);
    return b;
}
__device__ __forceinline__ void xcd_barrier_complete(unsigned* bar, unsigned x, unsigned& nloc, unsigned& nx) {
    const unsigned G = gridDim.x * gridDim.y * gridDim.z;
    unsigned sum, cnt, mine, sp = 0u;
    for (;;) {
        sum = 0u; cnt = 0u; mine = 0u;
#pragma unroll
        for (unsigned j = 0; j < 16; ++j) { const unsigned c = xb_ld(&bar[XB_XCNT(j)]); sum += c; cnt += (c > 0u) ? 1u : 0u; mine = (j == x) ? c : mine; }
        if (sum == G) break;
        __builtin_amdgcn_s_sleep(1);
        if ((++sp & 255u) == 0u) { if (xb_ld(&bar[XB_TMO])) break; if (sp > XB_SPIN_CAP) { atomicAdd(&bar[XB_TMO], 1u); break; } }
    }
    nloc = mine > 0u ? mine : 1u; nx = cnt > 0u ? cnt : 1u;
}

__device__ __forceinline__ void xcd_barrier(const XcdBarrier& b) {
    asm volatile("s_waitcnt vmcnt(0)" ::: "memory");
    __syncthreads();
    if (threadIdx.x == 0) {
        unsigned* bar = b.bar;
        __builtin_amdgcn_s_waitcnt(0);
        unsigned nloc = b.st[0], nx = b.st[1];
        if (nloc == 0u) { xcd_barrier_complete(bar, b.x, nloc, nx); b.st[0] = nloc; b.st[1] = nx; }
        const unsigned old = xb_add(&bar[XB_XSUB(b.x)], 1u);
        const unsigned gen = old / nloc;
        if (old + 1u == (gen + 1u) * nloc) {
            __builtin_amdgcn_fence(__ATOMIC_RELEASE, "agent");
            asm volatile("s_waitcnt vmcnt(0)" ::: "memory");
            const unsigned og = xb_add(&bar[XB_TOP], 1u);
            const unsigned tg = og / nx;
            if (og + 1u == (tg + 1u) * nx) xb_add(&bar[XB_TOPGEN], 1u);
            else XB_SPIN(xb_ld(&bar[XB_TOPGEN]) == tg, bar);
            __builtin_amdgcn_fence(__ATOMIC_ACQUIRE, "agent");
            xb_add(&bar[XB_XGEN(b.x)], 1u);
            asm volatile("s_waitcnt vmcnt(0)" ::: "memory");
        } else {
            XB_SPIN(xb_ld(&bar[XB_XGEN(b.x)]) == gen, bar);
            __builtin_amdgcn_fence(__ATOMIC_ACQUIRE, "agent");
            asm volatile("s_waitcnt vmcnt(0)" ::: "memory");
        }
    }
    __syncthreads();
}

typedef short s16x4 __attribute__((ext_vector_type(4)));
typedef float f32x16 __attribute__((ext_vector_type(16)));
typedef float f32x2_t __attribute__((ext_vector_type(2)));
typedef __bf16 bf16x2_t __attribute__((ext_vector_type(2)));
typedef unsigned u32x2 __attribute__((ext_vector_type(2)));
#define DI __device__ __forceinline__
DI unsigned cvtpk(float lo, float hi) { f32x2_t v = {lo, hi}; bf16x2_t b = __builtin_convertvector(v, bf16x2_t); return __builtin_bit_cast(unsigned, b); }
DI float bf2f(unsigned short b) { return __uint_as_float((unsigned)b << 16); }
DI float wave_sum(float v) {
#pragma unroll
    for (int o = 1; o < 64; o <<= 1) v += __shfl_xor(v, o);
    return v;
}
struct Args { const float* in[19]; float* out; unsigned char* ws; int ph_lo, ph_hi, li, pad; };
enum { I_XP = 0, I_XS, I_CK, I_CV, I_SC, I_SG, I_LN0G, I_LN0B, I_WIN, I_RB, I_CW, I_ALOG, I_DTB, I_GNW, I_WA, I_WB, I_WO, I_LNG, I_LNB };
struct Frame {
    LAS unsigned char* lds; volatile LAS unsigned* MISC; gu32* ctl;
    int tid, lane, wave, vcu, G, bx;
};

DI int win_dst_row(int n) { return n < 4096 ? n : (n < 4112 ? 6144 + (n - 4096) : 4096 + (n - 4112)); }
template <bool WINMAP> DI void tr_item(const float* W, int N, bf16* WT, int ldk, int koff, int kb, int nb, LAS float* scr, int lane) {
    const int k0 = 64 * kb, n0 = 32 * nb;
#pragma unroll 8
    for (int i = 0; i < 32; ++i) { const int kk = 2 * i + (lane >> 5), n = n0 + (lane & 31); scr[kk * 33 + (lane & 31)] = (n < N) ? W[(size_t)(k0 + kk) * N + n] : 0.f; }
    LDS_WAIT(); asm volatile("" ::: "memory");
    const int c = lane & 7;
#pragma unroll
    for (int j = 0; j < 4; ++j) { const int nn = (lane >> 3) + 8 * j, n = n0 + nn; const LAS float* s = scr + (8 * c) * 33 + nn;
        v4u o; o.x = pk2(s[0 * 33], s[1 * 33]); o.y = pk2(s[2 * 33], s[3 * 33]); o.z = pk2(s[4 * 33], s[5 * 33]); o.w = pk2(s[6 * 33], s[7 * 33]);
        if (n < N) { const int dr = WINMAP ? win_dst_row(n) : n; *(GAS v4u*)(WT + (size_t)dr * ldk + koff + k0 + 8 * c) = o; } }
    LDS_WAIT(); asm volatile("" ::: "memory");
}
DI void ln_row(const float* src, const float* g, const float* b, float* hout, bf16* hbout, int lane) {
    const GAS f32x4* xr = (const GAS f32x4*)src + lane;
    f32x4 v[4]; float s = 0.f;
#pragma unroll
    for (int j = 0; j < 4; ++j) { v[j] = xr[64 * j]; s += (v[j].x + v[j].y) + (v[j].z + v[j].w); }
    const float mean = wave_sum(s) * (1.f / D); float s2 = 0.f;
#pragma unroll
    for (int j = 0; j < 4; ++j) { v[j] = v[j] - mean; s2 += (v[j].x * v[j].x + v[j].y * v[j].y) + (v[j].z * v[j].z + v[j].w * v[j].w); }
    const float rstd = 1.f / sqrtf(wave_sum(s2) * (1.f / D) + LN_EPS);
    GAS f32x4* ho = (GAS f32x4*)hout + lane; GAS unsigned long long* o8 = (GAS unsigned long long*)hbout + lane;
#pragma unroll
    for (int j = 0; j < 4; ++j) { const f32x4 gg = ((const GAS f32x4*)g)[lane + 64 * j], bb = ((const GAS f32x4*)b)[lane + 64 * j];
        const f32x4 y = v[j] * rstd * gg + bb; ho[64 * j] = y;
        o8[64 * j] = (unsigned long long)pk2(y.x, y.y) | ((unsigned long long)pk2(y.z, y.w) << 32); }
}
DI void p0_prologue(Frame& F, const Args& A) {
    unsigned char* ws = A.ws;
    LAS float* scr = (LAS float*)(F.lds + RING_OFF + F.wave * 16384);
    const int gw = F.vcu * NWAVES + F.wave, NGW = F.G * NWAVES;
    constexpr int NB_IN = (IN_DIM + 31) / 32;
    constexpr int IT_IN = 16 * NB_IN, IT_A = 8 * 32, IT_O = 16 * 32, IT_L = IT_IN + 2 * IT_A + IT_O;
    for (int it = gw; it < DEPTH * IT_L; it += NGW) {
        const int l = it / IT_L; int r = it % IT_L;
        bf16* WinT = (bf16*)(ws + WS_WIN) + (size_t)l * NIN * D; bf16* WabT = (bf16*)(ws + WS_WAB) + (size_t)l * D * 1024; bf16* WoT = (bf16*)(ws + WS_WO) + (size_t)l * D * D;
        if (r < IT_IN) { tr_item<true>(A.in[I_WIN] + (size_t)l * D * IN_DIM, IN_DIM, WinT, D, 0, r / NB_IN, r % NB_IN, scr, F.lane); continue; } r -= IT_IN;
        if (r < IT_A) { tr_item<false>(A.in[I_WA] + (size_t)l * AW * D, D, WabT, 1024, 0, r / 32, r % 32, scr, F.lane); continue; } r -= IT_A;
        if (r < IT_A) { tr_item<false>(A.in[I_WB] + (size_t)l * BW * D, D, WabT, 1024, 512, r / 32, r % 32, scr, F.lane); continue; } r -= IT_A;
        tr_item<false>(A.in[I_WO] + (size_t)l * D * D, D, WoT, D, 0, r / 32, r % 32, scr, F.lane);
    }
    { const int gt = F.vcu * (NWAVES * 64) + F.tid, NGT = F.G * NWAVES * 64; constexpr int PER_L = (NIN - IN_DIM) * D * 2 / 16;
      for (int i = gt; i < DEPTH * PER_L; i += NGT) { const int l = i / PER_L, r = i % PER_L;
          *(GAS v4u*)((unsigned char*)ws + WS_WIN + ((size_t)l * NIN + IN_DIM) * D * 2 + (size_t)r * 16) = (v4u){0u, 0u, 0u, 0u}; } }
    float* H = A.out + O_Y; bf16* HB = (bf16*)(ws + WS_HB);
    for (int m = gw; m < M; m += NGW) {
        const float* src = (m < MP) ? A.in[I_XP] + (size_t)m * D : A.in[I_XS] + (size_t)(m - MP) * D;
        ln_row(src, A.in[I_LN0G], A.in[I_LN0B], H + (size_t)m * D, HB + (size_t)m * D, F.lane);
    }
}

namespace att {
DI int crow(int r, int hi) { return (r & 3) + 8 * (r >> 2) + 4 * hi; }
typedef short v4i16_t __attribute__((ext_vector_type(4)));
DI s16x4 vtr(const LAS unsigned char* p) { return __builtin_bit_cast(s16x4, __builtin_amdgcn_ds_read_tr16_b64_v4i16((LAS v4i16_t*)p)); }
DI bf16x8 ldfrag(const bf16* p) { return *(const GAS bf16x8*)p; }
DI bf16x8 ldfrag(const float* p) { const f32x4 a = *(const GAS f32x4*)p, b = *(const GAS f32x4*)(p + 4); v4u w; w.x = cvtpk(a[0], a[1]); w.y = cvtpk(a[2], a[3]); w.z = cvtpk(b[0], b[1]); w.w = cvtpk(b[2], b[3]); return __builtin_bit_cast(bf16x8, w); }
struct State { f32x16 o0, o1; float m, l; };
DI bf16x8 packp(const f32x16& p, int s) { v4u w; w.x = cvtpk(p[8 * s], p[8 * s + 1]); w.y = cvtpk(p[8 * s + 2], p[8 * s + 3]); w.z = cvtpk(p[8 * s + 4], p[8 * s + 5]); w.w = cvtpk(p[8 * s + 6], p[8 * s + 7]); return __builtin_bit_cast(bf16x8, w); }
template <typename T> DI void tile(State& st, const bf16x8 (&qr)[4], const T* kb, const T* vb, int pitch, int nvalid, int dq, const LAS float* btab, LAS unsigned char* vl, int lane) {
    const int r32 = lane & 31, hq = lane >> 5;
    bf16x8 kf[2][4];
#pragma unroll
    for (int sub = 0; sub < 2; ++sub) { int row = sub * 32 + r32; row = row < nvalid ? row : nvalid - 1;
#pragma unroll
        for (int ks = 0; ks < 4; ++ks) kf[sub][ks] = ldfrag(kb + (size_t)row * pitch + ks * 16 + hq * 8); }
    bf16x8 vreg[8];
#pragma unroll
    for (int i = 0; i < 8; ++i) { int row = i * 8 + (lane >> 3); row = row < nvalid ? row : nvalid - 1; vreg[i] = ldfrag(vb + (size_t)row * pitch + (lane & 7) * 8); }
    asm volatile("" ::: "memory");
#pragma unroll
    for (int i = 0; i < 8; ++i) { const int row = i * 8 + (lane >> 3); *(LAS bf16x8*)(vl + row * 128 + (((lane & 7) * 16) ^ (((row >> 1) & 1) << 6))) = vreg[i]; }
    f32x16 p0, p1;
#pragma unroll
    for (int r = 0; r < 16; ++r) { p0[r] = 0.f; p1[r] = 0.f; }
#pragma unroll
    for (int ks = 0; ks < 4; ++ks) { p0 = __builtin_amdgcn_mfma_f32_32x32x16_bf16(kf[0][ks], qr[ks], p0, 0, 0, 0); p1 = __builtin_amdgcn_mfma_f32_32x32x16_bf16(kf[1][ks], qr[ks], p1, 0, 0, 0); }
    if (dq >= 191) { const float bc = btab[191];
#pragma unroll
        for (int r = 0; r < 16; ++r) { p0[r] += bc; p1[r] += bc; }
    } else {
#pragma unroll
        for (int r = 0; r < 16; ++r) { int i0 = dq + r32 - crow(r, hq) + 63; int i1 = i0 - 32;
            i0 = i0 < 0 ? 0 : (i0 > 191 ? 191 : i0); i1 = i1 < 0 ? 0 : (i1 > 191 ? 191 : i1); p0[r] += btab[i0]; p1[r] += btab[i1]; }
    }
    if (nvalid < 64) {
#pragma unroll
        for (int r = 0; r < 16; ++r) { if (crow(r, hq) >= nvalid) p0[r] = -INFINITY; if (crow(r, hq) + 32 >= nvalid) p1[r] = -INFINITY; }
    }
    float mx = p0[0];
#pragma unroll
    for (int r = 1; r < 16; ++r) mx = fmaxf(mx, p0[r]);
#pragma unroll
    for (int r = 0; r < 16; ++r) mx = fmaxf(mx, p1[r]);
    mx = fmaxf(mx, __shfl_xor(mx, 32));
    const float mnew = fmaxf(st.m, mx), alpha = __builtin_amdgcn_exp2f(st.m - mnew); st.m = mnew;
    float sum = 0.f;
#pragma unroll
    for (int r = 0; r < 16; ++r) { p0[r] = __builtin_amdgcn_exp2f(p0[r] - mnew); p1[r] = __builtin_amdgcn_exp2f(p1[r] - mnew); sum += p0[r] + p1[r]; }
    st.l = st.l * alpha + sum;
#pragma unroll
    for (int r = 0; r < 16; ++r) { st.o0[r] *= alpha; st.o1[r] *= alpha; }
    bf16x8 pb[4]; pb[0] = packp(p0, 0); pb[1] = packp(p0, 1); pb[2] = packp(p1, 0); pb[3] = packp(p1, 1);
    asm volatile("" ::: "memory");
    const int blk = (lane >> 4) & 1, qq = (lane & 15) >> 2, pp = lane & 3, swz = ((qq >> 1) & 1) << 6;
#pragma unroll
    for (int s4 = 0; s4 < 4; ++s4) {
        const int rb = 16 * s4 + 4 * hq + qq;
#pragma unroll
        for (int d0 = 0; d0 < 2; ++d0) {
            const int cb = (d0 * 64 + blk * 32 + pp * 8) ^ swz;
            const s16x4 lo = vtr(vl + rb * 128 + cb), hi = vtr(vl + (rb + 8) * 128 + cb);
            const bf16x8 a = __builtin_shufflevector(lo, hi, 0, 1, 2, 3, 4, 5, 6, 7);
            if (d0 == 0) st.o0 = __builtin_amdgcn_mfma_f32_32x32x16_bf16(a, pb[s4], st.o0, 0, 0, 0);
            else st.o1 = __builtin_amdgcn_mfma_f32_32x32x16_bf16(a, pb[s4], st.o1, 0, 0, 0);
        }
    }
    asm volatile("" ::: "memory");
}
DI void finish(State& st, bf16* Orow0, const bf16* Zrow0, int lane) {
    const int r32 = lane & 31, hq = lane >> 5;
    const float lt = st.l + __shfl_xor(st.l, 32), inv = 1.0f / lt;
#pragma unroll
    for (int d0 = 0; d0 < 2; ++d0)
#pragma unroll
        for (int g = 0; g < 4; ++g) { const int d = 32 * d0 + 8 * g + 4 * hq;
            const u32x2 z = *(const GAS u32x2*)(Zrow0 + (size_t)r32 * 512 + d);
            const f32x16& o = d0 ? st.o1 : st.o0;
            const float a0 = o[4 * g] * inv * __uint_as_float(z.x << 16), a1 = o[4 * g + 1] * inv * __uint_as_float(z.x & 0xffff0000u);
            const float a2 = o[4 * g + 2] * inv * __uint_as_float(z.y << 16), a3 = o[4 * g + 3] * inv * __uint_as_float(z.y & 0xffff0000u);
            u32x2 w; w.x = cvtpk(a0, a1); w.y = cvtpk(a2, a3);
            *(GAS u32x2*)(Orow0 + (size_t)r32 * 1024 + d) = w; }
}
}

DI void p_attention(Frame& F, const Args& A, int l) {
    unsigned char* ws = A.ws;
    bf16* OAB = (bf16*)(ws + WS_OAB); const bf16* KA = (const bf16*)(ws + WS_KA); const bf16* VA = (const bf16*)(ws + WS_VA); const bf16* SZA = (const bf16*)(ws + WS_SZA);
    LAS float* btab_all = (LAS float*)(F.lds + BIAS_OFF);
    for (int i = F.tid; i < AH * NREL; i += NWAVES * 64) btab_all[i] = A.in[I_RB][(size_t)l * AH * NREL + i] * LOG2E;
    __syncthreads();
    LAS unsigned char* vl = F.lds + RING_OFF + F.wave * 16384;
    const int lane = F.lane, r32 = lane & 31, hq = lane >> 5;
    constexpr int NU_P = BATCH * (SEQ / CHUNK) * 2, NU = NU_P + DECB;
    for (int u = F.vcu; u < NU; u += F.G) {
        att::State st;
#pragma unroll
        for (int r = 0; r < 16; ++r) { st.o0[r] = 0.f; st.o1[r] = 0.f; }
        st.m = -1e30f; st.l = 0.f;
        bf16x8 qr[4];
        if (u < NU_P) {
            const int b = u >> 8, c = (u & 255) >> 1, h = (u & 1) * 4 + (F.wave >> 1), hf = F.wave & 1;
            const size_t qrow0 = (size_t)b * SEQ + c * CHUNK + hf * 32;
            bf16* Qp = OAB + qrow0 * 1024 + h * 64;
#pragma unroll
            for (int ks = 0; ks < 4; ++ks) qr[ks] = att::ldfrag(Qp + (size_t)r32 * 1024 + ks * 16 + hq * 8);
            const LAS float* btab = btab_all + h * NREL;
            for (int j = (c >= 8 ? c - 8 : 0); j <= c; ++j) {
                const size_t kr0 = ((size_t)b * SEQ + j * CHUNK) * 512 + h * 64;
                att::tile<bf16>(st, qr, KA + kr0, VA + kr0, 512, 64, (c - j) * 64 + hf * 32, btab, vl, lane);
            }
            att::finish(st, Qp, SZA + qrow0 * 512 + h * 64, lane);
        } else {
            const int b = u - NU_P, h = F.wave;
            const size_t qrow0 = (size_t)MP + b * DECS;
            bf16* Qp = OAB + qrow0 * 1024 + h * 64;
#pragma unroll
            for (int ks = 0; ks < 4; ++ks) qr[ks] = att::ldfrag(Qp + (size_t)r32 * 1024 + ks * 16 + hq * 8);
            const LAS float* btab = btab_all + h * NREL;
            const float* ck = A.in[I_CK] + ((size_t)(l * DECB + b) * ATTW) * 512 + h * 64;
            const float* cv = A.in[I_CV] + ((size_t)(l * DECB + b) * ATTW) * 512 + h * 64;
            for (int j = 0; j < 8; ++j) att::tile<float>(st, qr, ck + (size_t)j * 64 * 512, cv + (size_t)j * 64 * 512, 512, 64, 512 - 64 * j, btab, vl, lane);
            att::tile<bf16>(st, qr, KA + qrow0 * 512 + h * 64, VA + qrow0 * 512 + h * 64, 512, 32, 0, btab, vl, lane);
            att::finish(st, Qp, SZA + qrow0 * 512 + h * 64, lane);
        }
    }
}

DI void p_gdn_slow(Frame& F, const Args& A, int l) {
    unsigned char* ws = A.ws;
    bf16* OAB = (bf16*)(ws + WS_OAB); const bf16* XB = (const bf16*)(ws + WS_XB); const float* G = (const float*)(ws + WS_G); const float* BETA = (const float*)(ws + WS_BETA);
    int sid = -1;
    if (F.vcu < 32) { if (F.wave == 0) sid = F.vcu; } else if (F.vcu < 64) sid = 32 + (F.vcu - 32) * 8 + F.wave;
    if (sid < 0) return;
    const bool prompt = sid < 32; const int sq = prompt ? sid : sid - 32; const int b = sq >> 3, h = sq & 7, T = prompt ? SEQ : DECS;
    const size_t rowbase = prompt ? (size_t)b * SEQ : (size_t)MP + b * DECS;
    const int e = F.lane, cq = h * 64 + e, ck = 512 + cq, cv = 1024 + cq;
    const float* cw = A.in[I_CW] + (size_t)l * 4 * BQKV;
    float wq[4], wk[4], wv[4];
#pragma unroll
    for (int i = 0; i < 4; ++i) { wq[i] = cw[i * BQKV + cq]; wk[i] = cw[i * BQKV + ck]; wv[i] = cw[i * BQKV + cv]; }
    float xq[3] = {0.f, 0.f, 0.f}, xk[3] = {0.f, 0.f, 0.f}, xv[3] = {0.f, 0.f, 0.f};
    float S[64];
#pragma unroll
    for (int d = 0; d < 64; ++d) S[d] = 0.f;
    if (!prompt) {
        const float* sc = A.in[I_SC] + ((size_t)(l * DECB + b) * 3) * BQKV;
#pragma unroll
        for (int i = 0; i < 3; ++i) { xq[i] = sc[i * BQKV + cq]; xk[i] = sc[i * BQKV + ck]; xv[i] = sc[i * BQKV + cv]; }
        const float* s0 = A.in[I_SG] + ((size_t)(l * DECB + b) * BH + h) * 4096;
#pragma unroll
        for (int d = 0; d < 64; ++d) S[d] = s0[d * 64 + e];
    }
    const float nw = A.in[I_GNW][l * 64 + e];
    const float nAexp = -expf(A.in[I_ALOG][l * 8 + h]), dtb = A.in[I_DTB][l * 8 + h];
    LAS float* kbuf = (LAS float*)(F.lds + RING_OFF + F.wave * 16384); LAS float* qbuf = kbuf + 64;
    for (int t = 0; t < T; ++t) {
        const size_t row = rowbase + t;
        const float nq = bf2f(XB[row * BQKV + cq]), nk = bf2f(XB[row * BQKV + ck]), nv = bf2f(XB[row * BQKV + cv]);
        const float aq = xq[0] * wq[0] + xq[1] * wq[1] + xq[2] * wq[2] + nq * wq[3];
        const float ak = xk[0] * wk[0] + xk[1] * wk[1] + xk[2] * wk[2] + nk * wk[3];
        const float av = xv[0] * wv[0] + xv[1] * wv[1] + xv[2] * wv[2] + nv * wv[3];
        xq[0] = xq[1]; xq[1] = xq[2]; xq[2] = nq; xk[0] = xk[1]; xk[1] = xk[2]; xk[2] = nk; xv[0] = xv[1]; xv[1] = xv[2]; xv[2] = nv;
        const float q = aq / (1.f + expf(-aq)), k = ak / (1.f + expf(-ak)), v = av / (1.f + expf(-av));
        const float sqq = wave_sum(q * q), skk = wave_sum(k * k);
        const float qn = q * (1.0f / sqrtf(sqq + NORM_EPS)) * 0.125f, kn = k * (1.0f / sqrtf(skk + NORM_EPS));
        const float xa = G[row * 8 + h] + dtb, sp = xa > 20.f ? xa : log1pf(expf(xa));
        const float g = nAexp * sp, beta = 1.0f / (1.0f + expf(-BETA[row * 8 + h])), a = expf(g);
        asm volatile("" ::: "memory");
        kbuf[e] = kn; qbuf[e] = qn;
        asm volatile("s_waitcnt lgkmcnt(0)" ::: "memory");
        float kS = 0.f;
#pragma unroll
        for (int d = 0; d < 64; ++d) kS += kbuf[d] * S[d];
        const float coef = beta * (v - a * kS);
        float o = 0.f;
#pragma unroll
        for (int d = 0; d < 64; ++d) { S[d] = a * S[d] + kbuf[d] * coef; o += qbuf[d] * S[d]; }
        asm volatile("s_waitcnt lgkmcnt(0)" ::: "memory");
        const float ms = wave_sum(o * o) * (1.f / 64.f);
        const float on = o * (1.0f / sqrtf(ms + NORM_EPS)) * nw;
        bf16* op = OAB + row * 1024 + 512 + cq;
        *op = (bf16)f2bf(on * bf2f(*op));
    }
    float* so = A.out + (prompt ? O_GP + ((size_t)(l * BATCH + b) * BH + h) * 4096 : O_GS + ((size_t)(l * DECB + b) * BH + h) * 4096);
#pragma unroll
    for (int d = 0; d < 64; ++d) so[d * 64 + e] = S[d];
}

DI void p_inproj(Frame& F, const Args& A, int l) {
    unsigned char* ws = A.ws;
    pg8::Gemm g{(const pg8::bf16_t*)(ws + WS_HB), (const pg8::bf16_t*)(ws + WS_WIN) + (size_t)l * NIN * D, M, NIN, D};
    pg8::StaticOrder S; S.init(M, NIN, F.G, F.bx);
    pg8::EpiInProj E{ws, A.out, A.in[I_ALOG] + l * 8, A.in[I_DTB] + l * 8, l};
    pg8::gemm_phase<pg8::EpiInProj, pg8::StaticOrder, true, true>(F.lds + RING_OFF, g, S, E);
}
DI void p_mix(Frame& F, const Args& A, int l) {
    unsigned char* ws = A.ws;
    pg8::Gemm g{(const pg8::bf16_t*)(ws + WS_OAB), (const pg8::bf16_t*)(ws + WS_WAB) + (size_t)l * D * 1024, M, D, 1024};
    pg8::StaticOrder S; S.init(M, D, F.G, F.bx);
    pg8::EpiMix E{ws};
    pg8::gemm_phase<pg8::EpiMix, pg8::StaticOrder, true, true>(F.lds + RING_OFF, g, S, E);
}
DI void p_outproj(Frame& F, const Args& A, int l) {
    unsigned char* ws = A.ws;
    pg8::Gemm g{(const pg8::bf16_t*)(ws + WS_MIX), (const pg8::bf16_t*)(ws + WS_WO) + (size_t)l * D * D, M, D, D};
    pg8::StaticOrder S; S.init(M, D, F.G, F.bx);
    pg8::EpiResid E{A.out + O_Y, (float*)(ws + WS_Z)};
    pg8::gemm_phase<pg8::EpiResid, pg8::StaticOrder, true, true>(F.lds + RING_OFF, g, S, E);
}
DI void p_ln(Frame& F, const Args& A, int l) {
    unsigned char* ws = A.ws;
    const float* Z = (const float*)(ws + WS_Z); float* H = A.out + O_Y; bf16* HB = (bf16*)(ws + WS_HB);
    const int gw = F.vcu * NWAVES + F.wave, NGW = F.G * NWAVES;
    for (int m = gw; m < M; m += NGW) ln_row(Z + (size_t)m * D, A.in[I_LNG] + (size_t)l * D, A.in[I_LNB] + (size_t)l * D, H + (size_t)m * D, HB + (size_t)m * D, F.lane);
}

#ifndef PH_MASK
#define PH_MASK 0xff
#endif
constexpr int PH_PER_LAYER = 7, N_PHASES = 1 + DEPTH * PH_PER_LAYER;
template <int PMASK> __global__ void __launch_bounds__(NWAVES * 64, 2) trunk_fwd(Args args) {
    extern __shared__ __attribute__((aligned(16))) unsigned char lds[];
    LAS unsigned char* const ldsb = (LAS unsigned char*)lds;
    for (int u = threadIdx.x; u < (BIAS_OFF - LDSCTL_OFF) / 4; u += NWAVES * 64) ((LAS unsigned*)(ldsb + LDSCTL_OFF))[u] = 0u;
    __syncthreads();
    const int lo = args.ph_lo, hi = args.ph_hi;
    if (hi - lo > 1) (void)xcd_barrier_post((unsigned*)((gu32*)(args.ws + WS_CTL) + CW_BAR), (volatile LAS unsigned*)(ldsb + MISC_OFF) + 8);
    for (int ph = lo; ph < hi; ++ph) {
        int tid = threadIdx.x, bx = blockIdx.x; asm volatile("" : "+v"(tid)); asm volatile("" : "+s"(bx));
        Frame F;
        F.lds = ldsb; F.MISC = (volatile LAS unsigned*)(ldsb + MISC_OFF);
        F.tid = tid; F.lane = tid & 63; F.wave = __builtin_amdgcn_readfirstlane(tid >> 6);
        F.G = gridDim.x; F.vcu = (F.G % 8 == 0) ? (bx % 8) * (F.G / 8) + bx / 8 : bx; F.bx = bx;
        F.ctl = (gu32*)(args.ws + WS_CTL);
        if (ph == 0) { if constexpr ((PMASK & 1) != 0) p0_prologue(F, args); }
        else {
            const int l = (ph - 1) / PH_PER_LAYER, s = (ph - 1) % PH_PER_LAYER;
            if (s == 0) { if constexpr ((PMASK & 2) != 0) p_inproj(F, args, l); }
            else if (s == 1) { if constexpr ((PMASK & 4) != 0) p_attention(F, args, l); }
            else if (s == 2) {   }
            else if (s == 3) { if constexpr ((PMASK & 16) != 0) p_gdn_slow(F, args, l); }
            else if (s == 4) { if constexpr ((PMASK & 32) != 0) p_mix(F, args, l); }
            else if (s == 5) { if constexpr ((PMASK & 64) != 0) p_outproj(F, args, l); }
            else { if constexpr ((PMASK & 128) != 0) p_ln(F, args, l); }
        }
        if (ph + 1 < hi) { XcdBarrier bar; bar.bar = (unsigned*)((gu32*)(args.ws + WS_CTL) + CW_BAR); bar.x = xb_xcc_id(); bar.st = (volatile LAS unsigned*)(ldsb + MISC_OFF) + 8; xcd_barrier(bar); }
    }
}

extern "C" void kernel_launch(void* const* d_in, const int* in_sizes, int n_in, void* d_out, int out_size, void* d_ws, size_t ws_size, hipStream_t stream) {
    static int grid = 0;
    if (grid == 0) {
        if (n_in != 19 || in_sizes[0] != MP * D || (size_t)out_size != O_END || ws_size < WS_END) {
            fprintf(stderr, "kernel_launch: unexpected shapes: n_in %d in0 %d out %d ws %zu (need %zu); nothing launched\n", n_in, n_in > 0 ? in_sizes[0] : -1, out_size, ws_size, (size_t)WS_END); grid = -1; return; }
        int dev = 0, cus = 0, per_cu = 0;
        if (hipGetDevice(&dev) != hipSuccess || hipDeviceGetAttribute(&cus, hipDeviceAttributeMultiprocessorCount, dev) != hipSuccess) { grid = -1; return; }
        bool okattr = true;
#define SETATTR(MK) okattr = okattr && (hipFuncSetAttribute((const void*)trunk_fwd<MK>, hipFuncAttributeMaxDynamicSharedMemorySize, LDS_BYTES) == hipSuccess)
#if MK_PER_PHASE
        SETATTR(1); SETATTR(2); SETATTR(4); SETATTR(16); SETATTR(32); SETATTR(64); SETATTR(128);
#else
        SETATTR(0xff);
#endif
        if (!okattr) { fprintf(stderr, "kernel_launch: hipFuncSetAttribute failed\n"); grid = -1; return; }
        (void)per_cu; (void)hipGetLastError();
        grid = cus;
    }
    if (grid < 0) return;
    if (hipMemsetAsync((char*)d_ws + WS_CTL, 0, CTL_ZERO_BYTES, stream) != hipSuccess) return;
    Args a{};
    for (int i = 0; i < 19; ++i) a.in[i] = (const float*)d_in[i];
    a.out = (float*)d_out; a.ws = (unsigned char*)d_ws;
#if MK_PER_PHASE
    for (int ph = 0; ph < N_PHASES; ++ph) {
        const int s = ph == 0 ? -1 : (ph - 1) % PH_PER_LAYER;
        if (s == 2) continue;
        a.ph_lo = ph; a.ph_hi = ph + 1; a.li = 0;
        const dim3 g(grid), b(NWAVES * 64);
        if (s == -1) hipLaunchKernelGGL(trunk_fwd<1>, g, b, LDS_BYTES, stream, a);
        else if (s == 0) hipLaunchKernelGGL(trunk_fwd<2>, g, b, LDS_BYTES, stream, a);
        else if (s == 1) hipLaunchKernelGGL(trunk_fwd<4>, g, b, LDS_BYTES, stream, a);
        else if (s == 3) hipLaunchKernelGGL(trunk_fwd<16>, g, b, LDS_BYTES, stream, a);
        else if (s == 4) hipLaunchKernelGGL(trunk_fwd<32>, g, b, LDS_BYTES, stream, a);
        else if (s == 5) hipLaunchKernelGGL(trunk_fwd<64>, g, b, LDS_BYTES, stream, a);
        else hipLaunchKernelGGL(trunk_fwd<128>, g, b, LDS_BYTES, stream, a);
    }
#else
    a.ph_lo = 0; a.ph_hi = N_PHASES; a.li = 0;
    hipLaunchKernelGGL(trunk_fwd<0xff>, dim3(grid), dim3(NWAVES * 64), LDS_BYTES, stream, a);
#endif
}
```

```cpp
#include <hip/hip_runtime.h>
#include <cstdio>
#include <cstdint>

#ifndef MK_PER_PHASE
#define MK_PER_PHASE 0
#endif

constexpr int D = 1024, BATCH = 4, SEQ = 8192, DEPTH = 2, DECB = 32, DECS = 32, PAST = 4096;
constexpr int MP = BATCH * SEQ, MS = DECB * DECS, M = MP + MS;
constexpr int CHUNK = 64, ATTW = 512, AH = 8, AD = 64, AW = 512, NREL = 192, RELMAX = 128;
constexpr int BH = 8, BD = 64, BW = 512, BQKV = 1536;
constexpr int IN_DIM = 6160, NIN = 6400;
constexpr float LN_EPS = 1e-5f, NORM_EPS = 1e-6f;
constexpr float ALPHA = 1.41421356237309515f;
constexpr float LOG2E = 1.4426950408889634f;
constexpr float QSCALE = 0.125f * LOG2E;

constexpr size_t O_Y = 0;
constexpr size_t O_KP = (size_t)M * D;
constexpr size_t O_VP = O_KP + (size_t)DEPTH * BATCH * ATTW * AW;
constexpr size_t O_CP = O_VP + (size_t)DEPTH * BATCH * ATTW * AW;
constexpr size_t O_GP = O_CP + (size_t)DEPTH * BATCH * 3 * BQKV;
constexpr size_t O_KS = O_GP + (size_t)DEPTH * BATCH * BH * BD * BD;
constexpr size_t O_VS = O_KS + (size_t)DEPTH * DECB * DECS * AW;
constexpr size_t O_CS = O_VS + (size_t)DEPTH * DECB * DECS * AW;
constexpr size_t O_GS = O_CS + (size_t)DEPTH * DECB * 3 * BQKV;
constexpr size_t O_END = O_GS + (size_t)DEPTH * DECB * BH * BD * BD;
static_assert(O_END == 43585536, "output size");

constexpr size_t MiB = 1u << 20;
constexpr size_t WS_CTL = 0, CTL_ZERO_BYTES = 1 * MiB;
constexpr size_t WS_WIN = 1 * MiB;
constexpr size_t WS_WAB = 26 * MiB;
constexpr size_t WS_WO = 30 * MiB;
constexpr size_t WS_G = 34 * MiB;
constexpr size_t WS_BETA = WS_G + (size_t)M * 8 * 4;
constexpr size_t WS_HB = 37 * MiB;
constexpr size_t WS_KA = 103 * MiB, WS_VA = 136 * MiB, WS_SZA = 169 * MiB;
constexpr size_t WS_OAB = 202 * MiB;
constexpr size_t WS_XB = 268 * MiB;
constexpr size_t WS_GA = 367 * MiB, WS_GB = 433 * MiB;
constexpr size_t WS_END = 499 * MiB;
constexpr size_t WS_MIX = WS_HB;
constexpr size_t WS_Z = WS_GA;
static_assert(WS_BETA + (size_t)M * 8 * 4 <= WS_HB && WS_HB + (size_t)M * D * 2 <= WS_KA && WS_SZA + (size_t)M * 512 * 2 <= WS_OAB, "ws map");
static_assert(WS_OAB + (size_t)M * D * 2 <= WS_XB && WS_XB + (size_t)M * BQKV * 2 <= WS_GA && WS_GB + (size_t)M * D * 2 <= WS_END, "ws map 2");
static_assert(WS_Z + (size_t)M * D * 4 <= WS_END, "ws map 3");
constexpr int CW_TMO = 0, CW_CODE = 1, CW_BAR = 4096;

constexpr int RING_OFF = 0, RING_BYTES = 131072;
constexpr int LDSCTL_OFF = RING_BYTES, MISC_OFF = LDSCTL_OFF + 320;
constexpr int BIAS_OFF = RING_BYTES + 1024;
constexpr int LDS_BYTES = 147456;
static_assert(BIAS_OFF + AH * NREL * 4 <= LDS_BYTES && MISC_OFF + 128 <= BIAS_OFF, "LDS map");
constexpr int NWAVES = 8;

namespace pg8 {
#define PG8_LAS __attribute__((address_space(3)))
typedef unsigned short bf16_t;
typedef short bf16x8 __attribute__((ext_vector_type(8)));
typedef float f32x4 __attribute__((ext_vector_type(4)));
typedef unsigned u32x4 __attribute__((ext_vector_type(4)));
constexpr int BM = 256, BK = 64, HALF = 128, HTB = HALF * BK * 2  , STAGE_BYTES = 8 * HTB, NXCD = 8, WGM = 8;

__host__ __device__ __forceinline__ int lds_byte(int r, int c) { const int st = (r >> 4) * 2 + (c >> 5), rr = r & 15, cc = c & 31, ob = rr * 64 + cc * 2; return st * 1024 + (ob ^ (((ob >> 9) & 1) << 5)); }
__host__ __device__ __forceinline__ void stage_rc(int b, int& R, int& C) { const int st = b / 1024, sb = b % 1024, swz = sb ^ (((sb >> 9) & 1) << 5); R = (st >> 1) * 16 + swz / 64; C = (st & 1) * 32 + (swz % 64) / 2; }
__host__ __device__ __forceinline__ int perm32(int rho) { const int n = rho >> 4, i = rho & 15; return 8 * (i >> 2) + 4 * n + (i & 3); }

struct Unit { int pm, pn; };
struct Gemm { const bf16_t* A; const bf16_t* Bt; int M, N, K; };

struct StaticOrder {
    int nM, nN, nwg, G, c;
    __host__ __device__ void init(int M, int N, int G_, int c_) { nM = M / BM; nN = N / BM; nwg = nM * nN; G = G_; c = c_; }
    __host__ __device__ bool next(int i, Unit& u) const {
        const long L = (long)i * G + c; if (L >= nwg) return false;
        int wgid = (int)L; { const int q = nwg / NXCD, r = nwg % NXCD, xcd = wgid % NXCD, off = wgid / NXCD; wgid = (xcd < r ? xcd * (q + 1) : r * (q + 1) + (xcd - r) * q) + off; }
        const int nig = WGM * nN, gid = wgid / nig, fm = gid * WGM, gsz = (nM - fm) < WGM ? (nM - fm) : WGM;
        u.pm = fm + ((wgid % nig) % gsz); u.pn = (wgid % nig) / gsz; return true;
    }
    __device__ __forceinline__ void a_ready(const Unit&) const {}
    __device__ __forceinline__ void done(const Unit&) const {}
};


__device__ __forceinline__ unsigned cvt_pk_bf16(float lo, float hi) { unsigned r; asm volatile("v_cvt_pk_bf16_f32 %0, %1, %2" : "=v"(r) : "v"(lo), "v"(hi)); return r; }
__device__ __forceinline__ float bf_lo(unsigned w) { return __uint_as_float(w << 16); }
__device__ __forceinline__ float bf_hi(unsigned w) { return __uint_as_float(w & 0xffff0000u); }
__device__ __forceinline__ float sigmoid_f(float x) { return __builtin_amdgcn_rcpf(1.0f + __expf(-x)); }
__device__ __forceinline__ float silu_f(float x) { return x * sigmoid_f(x); }
__device__ __forceinline__ u32x4 pack8(const f32x4& a, const f32x4& b) { u32x4 w; w.x = cvt_pk_bf16(a[0], a[1]); w.y = cvt_pk_bf16(a[2], a[3]); w.z = cvt_pk_bf16(b[0], b[1]); w.w = cvt_pk_bf16(b[2], b[3]); return w; }

template <int ACT  > __device__ __forceinline__ void epi_store_bf16(const f32x4 (&acc)[2][2][4][2], unsigned char* base, unsigned off0, unsigned ldb  , float scale) {
#pragma unroll
    for (int ai = 0; ai < 2; ++ai)
#pragma unroll
        for (int m = 0; m < 4; ++m) {
#pragma unroll
            for (int bj = 0; bj < 2; ++bj) {
                f32x4 v0 = acc[ai][bj][m][0], v1 = acc[ai][bj][m][1];
                if (ACT == 0) { v0 = v0 * scale; v1 = v1 * scale; }
                if (ACT == 1) {
#pragma unroll
                    for (int j = 0; j < 4; ++j) { v0[j] = silu_f(v0[j]); v1[j] = silu_f(v1[j]); } }
                if (ACT == 2) {
#pragma unroll
                    for (int j = 0; j < 4; ++j) { v0[j] = sigmoid_f(v0[j]); v1[j] = sigmoid_f(v1[j]); } }
                *(u32x4*)(base + (off0 + (unsigned)(ai * HALF + m * 16) * ldb + (unsigned)(bj * HALF * 2))) = pack8(v0, v1);
            }
            asm volatile("" ::: "memory");
        }
}
__device__ __forceinline__ void epi_store_f32_rows(const f32x4 (&acc)[2][2][4][2], unsigned char* base, unsigned off0, unsigned ldb, int rt0, int r_lo, int r_hi) {
#pragma unroll
    for (int ai = 0; ai < 2; ++ai)
#pragma unroll
        for (int m = 0; m < 4; ++m) {
            const int rt = rt0 + ai * HALF + m * 16;
            if (rt >= r_lo && rt < r_hi) {
#pragma unroll
                for (int bj = 0; bj < 2; ++bj) {
                    unsigned char* p = base + (off0 + (unsigned)(ai * HALF + m * 16) * ldb + (unsigned)(bj * HALF * 4));
                    *(f32x4*)p = acc[ai][bj][m][0]; *(f32x4*)(p + 16) = acc[ai][bj][m][1];
                }
            }
            asm volatile("" ::: "memory");
        }
}
struct EpiInProj {
    static constexpr bool PERM = true, AFTER_DRAIN = false; static constexpr int MIDK = 0;
    unsigned char* ws; float* out; const float* a_log; const float* dt_bias; int l;
    __device__ __forceinline__ void operator()(const f32x4 (&acc)[2][2][4][2], const Unit& u, int wr, int wc, int fr, int fq) const {
        const int pn = u.pn, pm = u.pm;
        const int rt0 = wr * 64 + fr;
        const int ct0 = wc * 32 + 8 * fq;
        const unsigned row0 = (unsigned)pm * BM + rt0;
        if (pn < 2) {
            epi_store_bf16<0>(acc, ws + WS_OAB, (row0 * 1024u + pn * 256 + ct0) * 2u, 2048u, QSCALE);
        } else if (pn < 6) {
            const int isv = (pn >= 4); const unsigned col = (unsigned)(pn - (isv ? 4 : 2)) * 256 + ct0;
            epi_store_bf16<0>(acc, ws + (isv ? WS_VA : WS_KA), (row0 * 512u + col) * 2u, 1024u, 1.0f);
            if (pm >= 128) {
                unsigned char* ob = (unsigned char*)(out + (isv ? O_VS : O_KS) + (size_t)l * DECB * DECS * AW);
                epi_store_f32_rows(acc, ob, ((row0 - MP) * 512u + col) * 4u, 2048u, rt0, 0, 256);
            } else if ((pm & 31) >= 30) {
                unsigned char* ob = (unsigned char*)(out + (isv ? O_VP : O_KP) + (size_t)l * BATCH * ATTW * AW);
                epi_store_f32_rows(acc, ob, ((((unsigned)(pm >> 5) * ATTW + ((pm & 31) - 30) * 256 + rt0) * 512u) + col) * 4u, 2048u, rt0, 0, 256);
            }
        } else if (pn < 8) {
            epi_store_bf16<1>(acc, ws + WS_SZA, (row0 * 512u + (pn - 6) * 256 + ct0) * 2u, 1024u, 1.0f);
        } else if (pn < 14) {
            const unsigned col = (unsigned)(pn - 8) * 256 + ct0;
            epi_store_bf16<0>(acc, ws + WS_XB, (row0 * (unsigned)BQKV + col) * 2u, BQKV * 2u, 1.0f);
            if (pm >= 128) {
                float* oCs = out + O_CS + (size_t)l * DECB * 3 * BQKV;
#pragma unroll
                for (int ai = 0; ai < 2; ++ai)
#pragma unroll
                    for (int m = 0; m < 4; ++m) { const int rs = (int)(row0 - MP) + ai * HALF + m * 16, t = rs & 31;
                        if (t >= 29) {
#pragma unroll
                            for (int bj = 0; bj < 2; ++bj) { float* o = oCs + ((size_t)(rs >> 5) * 3 + (t - 29)) * BQKV + col + bj * HALF; *(f32x4*)o = acc[ai][bj][m][0]; *(f32x4*)(o + 4) = acc[ai][bj][m][1]; } }
                        asm volatile("" ::: "memory"); }
            } else if ((pm & 31) == 31) {
                unsigned char* ob = (unsigned char*)(out + O_CP + (size_t)l * BATCH * 3 * BQKV);
                epi_store_f32_rows(acc, ob, ((((unsigned)(pm >> 5) * 3 + (unsigned)(rt0 - 253)) * BQKV) + col) * 4u, BQKV * 4u, rt0, 253, 256);
            }
        } else if (pn < 16) {
            epi_store_bf16<1>(acc, ws + WS_OAB, (row0 * 1024u + 512 + (pn - 14) * 256 + ct0) * 2u, 2048u, 1.0f);
        } else if (pn < 24) {
            epi_store_bf16<2>(acc, ws + (pn < 20 ? WS_GA : WS_GB), (row0 * 1024u + ((pn - 16) & 3) * 256 + ct0) * 2u, 2048u, 1.0f);
        } else {
            if (wc == 0 && fq < 2) {
                float* G = (float*)(ws + WS_G); float* BETA = (float*)(ws + WS_BETA);
#pragma unroll
                for (int ai = 0; ai < 2; ++ai)
#pragma unroll
                    for (int m = 0; m < 4; ++m) {
                        const size_t row = (size_t)row0 + ai * HALF + m * 16;
                        f32x4 v0 = acc[ai][0][m][0], v1 = acc[ai][0][m][1];
                        float* dst = (fq == 0 ? G : BETA) + row * 8;
                        *(f32x4*)dst = v0; *(f32x4*)(dst + 4) = v1;
                        asm volatile("" ::: "memory");
                    }
            }
        }
    }
};

struct EpiMix {
    static constexpr bool PERM = true, AFTER_DRAIN = false; static constexpr int MIDK = 8;
    unsigned char* ws;
    __device__ __forceinline__ void mid(f32x4 (&acc)[2][2][4][2], const Unit& u, int wr, int wc, int fr, int fq) const {
        unsigned off0 = (((unsigned)u.pm * BM + wr * 64 + fr) * 1024u + u.pn * BM + wc * 32 + 8 * fq) * 2u;
        asm volatile("" : "+v"(off0));
        const unsigned char* GA = ws + WS_GA; const unsigned char* GB = ws + WS_GB;
#pragma unroll
        for (int ai = 0; ai < 2; ++ai)
#pragma unroll
            for (int m = 0; m < 4; ++m) {
#pragma unroll
                for (int bj = 0; bj < 2; ++bj) {
                    const unsigned off = off0 + (unsigned)(ai * HALF + m * 16) * 2048u + (unsigned)(bj * HALF * 2);
                    const u32x4 a = *(const u32x4*)(GA + off), b = *(const u32x4*)(GB + off);
                    f32x4 r0, r1;
                    r0[0] = bf_lo(a.x) * __builtin_amdgcn_rcpf(bf_lo(b.x)); r0[1] = bf_hi(a.x) * __builtin_amdgcn_rcpf(bf_hi(b.x));
                    r0[2] = bf_lo(a.y) * __builtin_amdgcn_rcpf(bf_lo(b.y)); r0[3] = bf_hi(a.y) * __builtin_amdgcn_rcpf(bf_hi(b.y));
                    r1[0] = bf_lo(a.z) * __builtin_amdgcn_rcpf(bf_lo(b.z)); r1[1] = bf_hi(a.z) * __builtin_amdgcn_rcpf(bf_hi(b.z));
                    r1[2] = bf_lo(a.w) * __builtin_amdgcn_rcpf(bf_lo(b.w)); r1[3] = bf_hi(a.w) * __builtin_amdgcn_rcpf(bf_hi(b.w));
                    acc[ai][bj][m][0] = acc[ai][bj][m][0] * r0; acc[ai][bj][m][1] = acc[ai][bj][m][1] * r1;
                }
                asm volatile("" ::: "memory");
            }
    }
    __device__ __forceinline__ void operator()(const f32x4 (&acc)[2][2][4][2], const Unit& u, int wr, int wc, int fr, int fq) const {
        const unsigned off0 = (((unsigned)u.pm * BM + wr * 64 + fr) * 1024u + u.pn * BM + wc * 32 + 8 * fq) * 2u;
        const unsigned char* GB = ws + WS_GB; unsigned char* MIX = ws + WS_MIX;
#pragma unroll
        for (int ai = 0; ai < 2; ++ai)
#pragma unroll
            for (int m = 0; m < 4; ++m) {
#pragma unroll
                for (int bj = 0; bj < 2; ++bj) {
                    const unsigned off = off0 + (unsigned)(ai * HALF + m * 16) * 2048u + (unsigned)(bj * HALF * 2);
                    const u32x4 b = *(const u32x4*)(GB + off);
                    f32x4 v0 = acc[ai][bj][m][0], v1 = acc[ai][bj][m][1];
                    v0[0] *= bf_lo(b.x); v0[1] *= bf_hi(b.x); v0[2] *= bf_lo(b.y); v0[3] *= bf_hi(b.y);
                    v1[0] *= bf_lo(b.z); v1[1] *= bf_hi(b.z); v1[2] *= bf_lo(b.w); v1[3] *= bf_hi(b.w);
                    *(u32x4*)(MIX + off) = pack8(v0, v1);
                }
                asm volatile("" ::: "memory");
            }
    }
};

struct EpiResid {
    static constexpr bool PERM = false, AFTER_DRAIN = false; static constexpr int MIDK = 0;
    const float* H; float* Z;
    __device__ __forceinline__ void operator()(const f32x4 (&acc)[2][2][4][2], const Unit& u, int wr, int wc, int fr, int fq) const {
        const int row0 = u.pm * BM + wr * 64 + fr, col0 = u.pn * BM + wc * 32 + 4 * fq;
#pragma unroll
        for (int ai = 0; ai < 2; ++ai)
#pragma unroll
            for (int m = 0; m < 4; ++m) { const size_t off = (size_t)(row0 + ai * HALF + m * 16) * D + col0;
#pragma unroll
                for (int bj = 0; bj < 2; ++bj)
#pragma unroll
                    for (int n = 0; n < 2; ++n) { const f32x4 h = *(const f32x4*)(H + off + bj * HALF + n * 16); *(f32x4*)(Z + off + bj * HALF + n * 16) = h * ALPHA + acc[ai][bj][m][n]; } }
    }
};

template <class Epi, class Sched, bool ALIGN_EPI = false, bool SP2 = false>
__device__ __forceinline__ void gemm_phase(PG8_LAS unsigned char* lds, const Gemm g, const Sched& S, const Epi& E, const int tid_in) {
    const int tid = tid_in, wid = __builtin_amdgcn_readfirstlane(tid >> 6), lane = tid & 63, wr = wid >> 2, wc = wid & 3, fr = lane & 15, fq = lane >> 4;
    const int K = g.K, nt = K / BK;
    unsigned voffA[2], voffB[2];
#pragma unroll
    for (int i = 0; i < 2; ++i) { int R, C; stage_rc(tid * 16 + i * 8192, R, C); const int Rb = Epi::PERM ? ((R & ~31) + perm32(R & 31)) : R;
        voffA[i] = (unsigned)(R * K + C) * 2u; voffB[i] = (unsigned)(Rb * K + C) * 2u; }
    const size_t kstep = (size_t)(BK * 2);
    const size_t hstep = (size_t)HALF * K * 2;
    const size_t tstep = 2 * hstep;
    const unsigned ldsw = (unsigned)wid * 1024u;
    const int aoff = lds_byte(wr * 64 + fr, fq * 8), boff = lds_byte(wc * 32 + fr, fq * 8);
#define PG8_SA(b, h) (((b) * 2 + (h)) * HTB)
#define PG8_SB(b, h) ((4 + (b) * 2 + (h)) * HTB)
#define PG8_STAGE(bufoff, gbase, voff) do { _Pragma("unroll") for (int _i = 0; _i < 2; ++_i) \
        __builtin_amdgcn_global_load_lds((const unsigned*)((const char*)(gbase) + (voff)[_i]), (PG8_LAS unsigned*)(lds + (bufoff) + ldsw + _i * 8192), 16, 0, 0); } while (0)
#define PG8_LDA(dst, b, h) do { _Pragma("unroll") for (int m = 0; m < 4; ++m) _Pragma("unroll") for (int k = 0; k < 2; ++k) dst[m][k] = *(const PG8_LAS bf16x8*)(lds + PG8_SA(b, h) + aoff + m * 2048 + k * 1024); } while (0)
#define PG8_LDB(dst, b, h) do { _Pragma("unroll") for (int n = 0; n < 2; ++n) _Pragma("unroll") for (int k = 0; k < 2; ++k) dst[n][k] = *(const PG8_LAS bf16x8*)(lds + PG8_SB(b, h) + boff + n * 2048 + k * 1024); } while (0)
#define PG8_MMA(ai, bj, At, Bt) do { __builtin_amdgcn_s_setprio(1); _Pragma("unroll") for (int m = 0; m < 4; ++m) _Pragma("unroll") for (int n = 0; n < 2; ++n) _Pragma("unroll") for (int k = 0; k < 2; ++k) \
        acc[ai][bj][m][n] = __builtin_amdgcn_mfma_f32_16x16x32_bf16(Bt[n][k], At[m][k], acc[ai][bj][m][n], 0, 0, 0); __builtin_amdgcn_s_setprio(0); } while (0)
#define PG8_WAIT_V(n) asm volatile("s_waitcnt vmcnt(" #n ")" ::: "memory")
#define PG8_WAIT_L(n) asm volatile("s_waitcnt lgkmcnt(" #n ")" ::: "memory")
#define PG8_BAR __builtin_amdgcn_s_barrier()
#define PG8_SCHED __builtin_amdgcn_sched_barrier(0)
    Unit cur, nxt; int ui = 0;
    if (!S.next(0, cur)) return;
    f32x4 acc[2][2][4][2];
#pragma unroll
    for (int a = 0; a < 2; ++a)
#pragma unroll
        for (int b = 0; b < 2; ++b)
#pragma unroll
            for (int m = 0; m < 4; ++m)
#pragma unroll
                for (int n = 0; n < 2; ++n) acc[a][b][m][n] = (f32x4){0.f, 0.f, 0.f, 0.f};
    bf16x8 At[4][2], B0[2][2], B1[2][2];
    const char* cA = (const char*)g.A + (size_t)cur.pm * tstep; const char* cB = (const char*)g.Bt + (size_t)cur.pn * tstep;
    S.a_ready(cur);
    if constexpr (SP2) {
        PG8_STAGE(PG8_SB(0, 0), cB, voffB); PG8_STAGE(PG8_SB(0, 1), cB + hstep, voffB); PG8_STAGE(PG8_SA(0, 0), cA, voffA); PG8_STAGE(PG8_SA(0, 1), cA + hstep, voffA);
        if (wr == 1) PG8_BAR;
        PG8_WAIT_V(2); PG8_BAR;
        PG8_STAGE(PG8_SB(1, 0), cB + kstep, voffB); PG8_STAGE(PG8_SA(1, 0), cA + kstep, voffA); PG8_STAGE(PG8_SB(1, 1), cB + hstep + kstep, voffB);
        PG8_WAIT_V(6); PG8_BAR;
    } else {
        PG8_STAGE(PG8_SB(0, 0), cB, voffB); PG8_STAGE(PG8_SA(0, 0), cA, voffA); PG8_STAGE(PG8_SB(0, 1), cB + hstep, voffB); PG8_STAGE(PG8_SA(0, 1), cA + hstep, voffA);
        if (wr == 1) PG8_BAR;
        PG8_WAIT_V(4); PG8_BAR;
        PG8_STAGE(PG8_SB(1, 0), cB + kstep, voffB); PG8_STAGE(PG8_SA(1, 0), cA + kstep, voffA); PG8_STAGE(PG8_SB(1, 1), cB + hstep + kstep, voffB);
        PG8_WAIT_V(6); PG8_BAR;
    }
    for (;;) {
        const bool has_next = S.next(ui + 1, nxt);
        const char* nA = has_next ? (const char*)g.A + (size_t)nxt.pm * tstep : cA; const char* nB = has_next ? (const char*)g.Bt + (size_t)nxt.pn * tstep : cB;
        for (int t = 0; t < nt; t += 2) {
            if constexpr (Epi::MIDK > 0) { if (t == Epi::MIDK) E.mid(acc, cur, wr, wc, fr, fq); }
            const bool last = (t == nt - 2);
            const char* a1 = cA + (size_t)(t + 1) * kstep;
            const char* a2 = last ? nA : cA + (size_t)(t + 2) * kstep; const char* b2 = last ? nB : cB + (size_t)(t + 2) * kstep;
            const char* a3 = a2 + kstep; const char* b3 = b2 + kstep;
            if (last && has_next) S.a_ready(nxt);
            if constexpr (SP2) {
            PG8_LDB(B0, 0, 0); PG8_LDB(B1, 0, 1); PG8_SCHED; PG8_LDA(At, 0, 0); PG8_STAGE(PG8_SA(1, 1), a1 + hstep, voffA);
            PG8_WAIT_V(8); PG8_WAIT_L(0); PG8_BAR; PG8_MMA(0, 0, At, B0); PG8_MMA(0, 1, At, B1); PG8_BAR; PG8_SCHED;
            PG8_LDA(At, 0, 1); PG8_STAGE(PG8_SB(0, 0), b2, voffB); PG8_STAGE(PG8_SB(0, 1), b2 + hstep, voffB); PG8_STAGE(PG8_SA(0, 0), a2, voffA);
            PG8_WAIT_V(8); PG8_WAIT_L(0); PG8_BAR; PG8_MMA(1, 0, At, B0); PG8_MMA(1, 1, At, B1); PG8_BAR; PG8_SCHED;
            PG8_LDB(B0, 1, 0); PG8_LDB(B1, 1, 1); PG8_SCHED; PG8_LDA(At, 1, 0); PG8_STAGE(PG8_SA(0, 1), a2 + hstep, voffA);
            PG8_WAIT_V(8); PG8_WAIT_L(0); PG8_BAR; PG8_MMA(0, 0, At, B0); PG8_MMA(0, 1, At, B1); PG8_BAR; PG8_SCHED;
            PG8_LDA(At, 1, 1); PG8_STAGE(PG8_SB(1, 0), b3, voffB); PG8_STAGE(PG8_SB(1, 1), b3 + hstep, voffB); PG8_STAGE(PG8_SA(1, 0), a3, voffA);
            PG8_WAIT_V(8); PG8_WAIT_L(0); PG8_BAR; PG8_MMA(1, 0, At, B0); PG8_MMA(1, 1, At, B1); PG8_BAR; PG8_SCHED;
            } else {
            PG8_LDB(B0, 0, 0); PG8_SCHED; PG8_LDA(At, 0, 0); PG8_STAGE(PG8_SA(1, 1), a1 + hstep, voffA);
            PG8_WAIT_L(8); PG8_BAR; PG8_WAIT_L(0); PG8_MMA(0, 0, At, B0); PG8_BAR; PG8_SCHED;
            PG8_LDB(B1, 0, 1); PG8_STAGE(PG8_SB(0, 0), b2, voffB);
            PG8_BAR; PG8_WAIT_L(0); PG8_MMA(0, 1, At, B1); PG8_BAR;
            PG8_LDA(At, 0, 1); PG8_STAGE(PG8_SA(0, 0), a2, voffA);
            PG8_BAR; PG8_WAIT_L(0); PG8_MMA(1, 0, At, B0); PG8_BAR; PG8_SCHED;
            PG8_STAGE(PG8_SB(0, 1), b2 + hstep, voffB);
            PG8_WAIT_V(6); PG8_BAR; PG8_MMA(1, 1, At, B1); PG8_BAR;
            PG8_LDB(B0, 1, 0); PG8_SCHED; PG8_LDA(At, 1, 0); PG8_STAGE(PG8_SA(0, 1), a2 + hstep, voffA);
            PG8_WAIT_L(8); PG8_BAR; PG8_WAIT_L(0); PG8_MMA(0, 0, At, B0); PG8_BAR; PG8_SCHED;
            PG8_LDB(B1, 1, 1); PG8_STAGE(PG8_SB(1, 0), b3, voffB);
            PG8_BAR; PG8_WAIT_L(0); PG8_MMA(0, 1, At, B1); PG8_BAR;
            PG8_LDA(At, 1, 1); PG8_STAGE(PG8_SA(1, 0), a3, voffA);
            PG8_BAR; PG8_WAIT_L(0); PG8_MMA(1, 0, At, B0); PG8_BAR; PG8_SCHED;
            PG8_STAGE(PG8_SB(1, 1), b3 + hstep, voffB);
            PG8_WAIT_V(6); PG8_BAR; PG8_MMA(1, 1, At, B1); PG8_BAR;
            }
        }
        if constexpr (ALIGN_EPI) { if (wr == 0) PG8_BAR; }
        if constexpr (!Epi::AFTER_DRAIN) { E(acc, cur, wr, wc, fr, fq); S.done(cur); }
        if (!has_next) break;
#pragma unroll
        for (int a = 0; a < 2; ++a)
#pragma unroll
            for (int b = 0; b < 2; ++b)
#pragma unroll
                for (int m = 0; m < 4; ++m)
#pragma unroll
                    for (int n = 0; n < 2; ++n) acc[a][b][m][n] = (f32x4){0.f, 0.f, 0.f, 0.f};
        cur = nxt; cA = nA; cB = nB; ++ui;
        if constexpr (ALIGN_EPI) { if (wr == 1) PG8_BAR; }
    }
    PG8_WAIT_V(0);
    if constexpr (!ALIGN_EPI) { if (wr == 0) PG8_BAR; }
    PG8_BAR;
    if constexpr (Epi::AFTER_DRAIN) { E.fused(acc, cur, wr, wc, fr, fq, lds, wid, lane); S.done(cur); }
#undef PG8_SA
#undef PG8_SB
#undef PG8_STAGE
#undef PG8_LDA
#undef PG8_LDB
#undef PG8_MMA
#undef PG8_WAIT_V
#undef PG8_WAIT_L
#undef PG8_BAR
#undef PG8_SCHED
}
}
#define GAS __attribute__((address_space(1)))
#define LAS __attribute__((address_space(3)))
typedef unsigned short bf16;
typedef unsigned v4u __attribute__((ext_vector_type(4)));
typedef float f32x4 __attribute__((ext_vector_type(4)));
typedef short bf16x8 __attribute__((ext_vector_type(8)));
typedef GAS unsigned gu32;
typedef GAS unsigned long long gu64;
#define RLX_AGENT __ATOMIC_RELAXED, __HIP_MEMORY_SCOPE_AGENT
#define LDS_WAIT() asm volatile("s_waitcnt lgkmcnt(0)" ::: "memory")
#define VM_WAIT() asm volatile("s_waitcnt vmcnt(0)" ::: "memory")
__device__ __forceinline__ unsigned long long rt() { return __builtin_amdgcn_s_memrealtime(); }
__device__ __forceinline__ unsigned f2bf(float f) { unsigned u = __builtin_bit_cast(unsigned, f); return (u + 0x7fffu + ((u >> 16) & 1u)) >> 16; }
__device__ __forceinline__ unsigned pk2(float lo, float hi) { return f2bf(lo) | (f2bf(hi) << 16); }

#define XB_TMO      128
#define XB_XCNT(j)  (256  + 64 * (j))
#define XB_XSUB(j)  (1280 + 64 * (j))
#define XB_XGEN(j)  (2304 + 64 * (j))
#define XB_TOP      3328
#define XB_TOPGEN   3392
#define XCD_BAR_WORDS 3456
#define XB_SPIN_CAP (1u << 18)

__device__ __forceinline__ unsigned xb_ld(unsigned* p)              { return __hip_atomic_load(p, __ATOMIC_RELAXED, __HIP_MEMORY_SCOPE_AGENT); }
__device__ __forceinline__ unsigned xb_add(unsigned* p, unsigned v) { return __hip_atomic_fetch_add(p, v, __ATOMIC_RELAXED, __HIP_MEMORY_SCOPE_AGENT); }
__device__ __forceinline__ unsigned xb_xcc_id() { return (unsigned)__builtin_amdgcn_s_getreg((3 << 11) | 20) & 0xFu; }
#define XB_SPIN(cond, bar) do { unsigned _sp = 0; while (cond) { __builtin_amdgcn_s_sleep(1); \
    if ((++_sp & 255u) == 0u) { if (xb_ld(&(bar)[XB_TMO])) break; if (_sp > XB_SPIN_CAP) { atomicAdd(&(bar)[XB_TMO], 1u); break; } } } } while (0)

struct XcdBarrier {
    unsigned* bar; unsigned x;
    volatile LAS unsigned* st;
};

__device__ __forceinline__ XcdBarrier xcd_barrier_post(unsigned* bar, volatile LAS unsigned* st) {
    XcdBarrier b; b.bar = bar; b.x = xb_xcc_id(); b.st = st;
    if (threadIdx.x == 0) (void)xb_add(&bar[XB_XCNT(b.x)], 1u);
    return b;
}
__device__ __forceinline__ void xcd_barrier_complete(unsigned* bar, unsigned x, unsigned& nloc, unsigned& nx) {
    const unsigned G = gridDim.x * gridDim.y * gridDim.z;
    unsigned sum, cnt, mine, sp = 0u;
    for (;;) {
        sum = 0u; cnt = 0u; mine = 0u;
#pragma unroll
        for (unsigned j = 0; j < 16; ++j) { const unsigned c = xb_ld(&bar[XB_XCNT(j)]); sum += c; cnt += (c > 0u) ? 1u : 0u; mine = (j == x) ? c : mine; }
        if (sum == G) break;
        __builtin_amdgcn_s_sleep(1);
        if ((++sp & 255u) == 0u) { if (xb_ld(&bar[XB_TMO])) break; if (sp > XB_SPIN_CAP) { atomicAdd(&bar[XB_TMO], 1u); break; } }
    }
    nloc = mine > 0u ? mine : 1u; nx = cnt > 0u ? cnt : 1u;
}

__device__ __forceinline__ void xcd_barrier(const XcdBarrier& b, const bool leader_thread) {
    asm volatile("s_waitcnt vmcnt(0)" ::: "memory");
    __syncthreads();
    if (leader_thread) {
        unsigned* bar = b.bar;
        __builtin_amdgcn_s_waitcnt(0);
        unsigned nloc = b.st[0], nx = b.st[1];
        if (nloc == 0u) { xcd_barrier_complete(bar, b.x, nloc, nx); b.st[0] = nloc; b.st[1] = nx; }
        const unsigned old = xb_add(&bar[XB_XSUB(b.x)], 1u);
        const unsigned gen = old / nloc;
        if (old + 1u == (gen + 1u) * nloc) {
            __builtin_amdgcn_fence(__ATOMIC_RELEASE, "agent");
            asm volatile("s_waitcnt vmcnt(0)" ::: "memory");
            const unsigned og = xb_add(&bar[XB_TOP], 1u);
            const unsigned tg = og / nx;
            if (og + 1u == (tg + 1u) * nx) xb_add(&bar[XB_TOPGEN], 1u);
            else XB_SPIN(xb_ld(&bar[XB_TOPGEN]) == tg, bar);
            __builtin_amdgcn_fence(__ATOMIC_ACQUIRE, "agent");
            xb_add(&bar[XB_XGEN(b.x)], 1u);
            asm volatile("s_waitcnt vmcnt(0)" ::: "memory");
        } else {
            XB_SPIN(xb_ld(&bar[XB_XGEN(b.x)]) == gen, bar);
            __builtin_amdgcn_fence(__ATOMIC_ACQUIRE, "agent");
            asm volatile("s_waitcnt vmcnt(0)" ::: "memory");
        }
    }
    __syncthreads();
}

typedef short s16x4 __attribute__((ext_vector_type(4)));
typedef float f32x16 __attribute__((ext_vector_type(16)));
typedef float f32x2_t __attribute__((ext_vector_type(2)));
typedef __bf16 bf16x2_t __attribute__((ext_vector_type(2)));
typedef unsigned u32x2 __attribute__((ext_vector_type(2)));
#define CAS __attribute__((address_space(4)))
#define DI __device__ __forceinline__
DI unsigned cvtpk(float lo, float hi) { f32x2_t v = {lo, hi}; bf16x2_t b = __builtin_convertvector(v, bf16x2_t); return __builtin_bit_cast(unsigned, b); }
DI float bf2f(unsigned short b) { return __uint_as_float((unsigned)b << 16); }
DI float wave_sum(float v) {
#pragma unroll
    for (int o = 1; o < 64; o <<= 1) v += __shfl_xor(v, o);
    return v;
}
struct Args { const float* in[19]; float* out; unsigned char* ws; int ph_lo, ph_hi, li, pad; };
enum { I_XP = 0, I_XS, I_CK, I_CV, I_SC, I_SG, I_LN0G, I_LN0B, I_WIN, I_RB, I_CW, I_ALOG, I_DTB, I_GNW, I_WA, I_WB, I_WO, I_LNG, I_LNB };
struct Frame {
    LAS unsigned char* lds; volatile LAS unsigned* MISC; gu32* ctl;
    int tid, lane, wave, vcu, G, bx;
};

DI int win_dst_row(int n) { return n < 4096 ? n : (n < 4112 ? 6144 + (n - 4096) : 4096 + (n - 4112)); }
template <bool WINMAP> DI void tr_item(const float* W, int N, bf16* WT, int ldk, int koff, int kb, int nb, LAS float* scr, int lane) {
    const int k0 = 64 * kb, n0 = 32 * nb;
#pragma unroll 8
    for (int i = 0; i < 32; ++i) { const int kk = 2 * i + (lane >> 5), n = n0 + (lane & 31); scr[kk * 33 + (lane & 31)] = (n < N) ? W[(size_t)(k0 + kk) * N + n] : 0.f; }
    LDS_WAIT(); asm volatile("" ::: "memory");
    const int c = lane & 7;
#pragma unroll
    for (int j = 0; j < 4; ++j) { const int nn = (lane >> 3) + 8 * j, n = n0 + nn; const LAS float* s = scr + (8 * c) * 33 + nn;
        v4u o; o.x = pk2(s[0 * 33], s[1 * 33]); o.y = pk2(s[2 * 33], s[3 * 33]); o.z = pk2(s[4 * 33], s[5 * 33]); o.w = pk2(s[6 * 33], s[7 * 33]);
        if (n < N) { const int dr = WINMAP ? win_dst_row(n) : n; *(GAS v4u*)(WT + (size_t)dr * ldk + koff + k0 + 8 * c) = o; } }
    LDS_WAIT(); asm volatile("" ::: "memory");
}
DI void ln_row(const float* src, const float* g, const float* b, float* hout, bf16* hbout, int lane) {
    const GAS f32x4* xr = (const GAS f32x4*)src + lane;
    f32x4 v[4]; float s = 0.f;
#pragma unroll
    for (int j = 0; j < 4; ++j) { v[j] = xr[64 * j]; s += (v[j].x + v[j].y) + (v[j].z + v[j].w); }
    const float mean = wave_sum(s) * (1.f / D); float s2 = 0.f;
#pragma unroll
    for (int j = 0; j < 4; ++j) { v[j] = v[j] - mean; s2 += (v[j].x * v[j].x + v[j].y * v[j].y) + (v[j].z * v[j].z + v[j].w * v[j].w); }
    const float rstd = 1.f / sqrtf(wave_sum(s2) * (1.f / D) + LN_EPS);
    GAS f32x4* ho = (GAS f32x4*)hout + lane; GAS unsigned long long* o8 = (GAS unsigned long long*)hbout + lane;
#pragma unroll
    for (int j = 0; j < 4; ++j) { const f32x4 gg = ((const GAS f32x4*)g)[lane + 64 * j], bb = ((const GAS f32x4*)b)[lane + 64 * j];
        const f32x4 y = v[j] * rstd * gg + bb; ho[64 * j] = y;
        o8[64 * j] = (unsigned long long)pk2(y.x, y.y) | ((unsigned long long)pk2(y.z, y.w) << 32); }
}
DI void p0_prologue(Frame& F, const CAS Args& A) {
    unsigned char* ws = A.ws;
    LAS float* scr = (LAS float*)(F.lds + RING_OFF + F.wave * 16384);
    const int gw = F.vcu * NWAVES + F.wave, NGW = F.G * NWAVES;
    constexpr int NB_IN = (IN_DIM + 31) / 32;
    constexpr int IT_IN = 16 * NB_IN, IT_A = 8 * 32, IT_O = 16 * 32, IT_L = IT_IN + 2 * IT_A + IT_O;
    for (int it = gw; it < DEPTH * IT_L; it += NGW) {
        const int l = it / IT_L; int r = it % IT_L;
        bf16* WinT = (bf16*)(ws + WS_WIN) + (size_t)l * NIN * D; bf16* WabT = (bf16*)(ws + WS_WAB) + (size_t)l * D * 1024; bf16* WoT = (bf16*)(ws + WS_WO) + (size_t)l * D * D;
        if (r < IT_IN) { tr_item<true>(A.in[I_WIN] + (size_t)l * D * IN_DIM, IN_DIM, WinT, D, 0, r / NB_IN, r % NB_IN, scr, F.lane); continue; } r -= IT_IN;
        if (r < IT_A) { tr_item<false>(A.in[I_WA] + (size_t)l * AW * D, D, WabT, 1024, 0, r / 32, r % 32, scr, F.lane); continue; } r -= IT_A;
        if (r < IT_A) { tr_item<false>(A.in[I_WB] + (size_t)l * BW * D, D, WabT, 1024, 512, r / 32, r % 32, scr, F.lane); continue; } r -= IT_A;
        tr_item<false>(A.in[I_WO] + (size_t)l * D * D, D, WoT, D, 0, r / 32, r % 32, scr, F.lane);
    }
    { const int gt = F.vcu * (NWAVES * 64) + F.tid, NGT = F.G * NWAVES * 64; constexpr int PER_L = (NIN - IN_DIM) * D * 2 / 16;
      for (int i = gt; i < DEPTH * PER_L; i += NGT) { const int l = i / PER_L, r = i % PER_L;
          *(GAS v4u*)((unsigned char*)ws + WS_WIN + ((size_t)l * NIN + IN_DIM) * D * 2 + (size_t)r * 16) = (v4u){0u, 0u, 0u, 0u}; } }
    float* H = A.out + O_Y; bf16* HB = (bf16*)(ws + WS_HB);
    for (int m = gw; m < M; m += NGW) {
        const float* src = (m < MP) ? A.in[I_XP] + (size_t)m * D : A.in[I_XS] + (size_t)(m - MP) * D;
        ln_row(src, A.in[I_LN0G], A.in[I_LN0B], H + (size_t)m * D, HB + (size_t)m * D, F.lane);
    }
}

namespace att {
DI int crow(int r, int hi) { return (r & 3) + 8 * (r >> 2) + 4 * hi; }
typedef short v4i16_t __attribute__((ext_vector_type(4)));
DI s16x4 vtr(const LAS unsigned char* p) { return __builtin_bit_cast(s16x4, __builtin_amdgcn_ds_read_tr16_b64_v4i16((LAS v4i16_t*)p)); }
DI bf16x8 ldfrag(const bf16* p) { return *(const GAS bf16x8*)p; }
DI bf16x8 ldfrag(const float* p) { const f32x4 a = *(const GAS f32x4*)p, b = *(const GAS f32x4*)(p + 4); v4u w; w.x = cvtpk(a[0], a[1]); w.y = cvtpk(a[2], a[3]); w.z = cvtpk(b[0], b[1]); w.w = cvtpk(b[2], b[3]); return __builtin_bit_cast(bf16x8, w); }
struct State { f32x16 o0, o1; float m, l; };
DI bf16x8 packp(const f32x16& p, int s) { v4u w; w.x = cvtpk(p[8 * s], p[8 * s + 1]); w.y = cvtpk(p[8 * s + 2], p[8 * s + 3]); w.z = cvtpk(p[8 * s + 4], p[8 * s + 5]); w.w = cvtpk(p[8 * s + 6], p[8 * s + 7]); return __builtin_bit_cast(bf16x8, w); }
template <typename T> DI void tile(State& st, const bf16x8 (&qr)[4], const T* kb, const T* vb, int pitch, int nvalid, int dq, const LAS float* btab, LAS unsigned char* vl, int lane) {
    const int r32 = lane & 31, hq = lane >> 5;
    bf16x8 kf[2][4];
#pragma unroll
    for (int sub = 0; sub < 2; ++sub) { int row = sub * 32 + r32; row = row < nvalid ? row : nvalid - 1;
#pragma unroll
        for (int ks = 0; ks < 4; ++ks) kf[sub][ks] = ldfrag(kb + (size_t)row * pitch + ks * 16 + hq * 8); }
    bf16x8 vreg[8];
#pragma unroll
    for (int i = 0; i < 8; ++i) { int row = i * 8 + (lane >> 3); row = row < nvalid ? row : nvalid - 1; vreg[i] = ldfrag(vb + (size_t)row * pitch + (lane & 7) * 8); }
    asm volatile("" ::: "memory");
#pragma unroll
    for (int i = 0; i < 8; ++i) { const int row = i * 8 + (lane >> 3); *(LAS bf16x8*)(vl + row * 128 + (((lane & 7) * 16) ^ (((row >> 1) & 1) << 6))) = vreg[i]; }
    f32x16 p0, p1;
#pragma unroll
    for (int r = 0; r < 16; ++r) { p0[r] = 0.f; p1[r] = 0.f; }
#pragma unroll
    for (int ks = 0; ks < 4; ++ks) { p0 = __builtin_amdgcn_mfma_f32_32x32x16_bf16(kf[0][ks], qr[ks], p0, 0, 0, 0); p1 = __builtin_amdgcn_mfma_f32_32x32x16_bf16(kf[1][ks], qr[ks], p1, 0, 0, 0); }
    if (dq >= 191) { const float bc = btab[191];
#pragma unroll
        for (int r = 0; r < 16; ++r) { p0[r] += bc; p1[r] += bc; }
    } else {
#pragma unroll
        for (int r = 0; r < 16; ++r) { int i0 = dq + r32 - crow(r, hq) + 63; int i1 = i0 - 32;
            i0 = i0 < 0 ? 0 : (i0 > 191 ? 191 : i0); i1 = i1 < 0 ? 0 : (i1 > 191 ? 191 : i1); p0[r] += btab[i0]; p1[r] += btab[i1]; }
    }
    if (nvalid < 64) {
#pragma unroll
        for (int r = 0; r < 16; ++r) { if (crow(r, hq) >= nvalid) p0[r] = -INFINITY; if (crow(r, hq) + 32 >= nvalid) p1[r] = -INFINITY; }
    }
    float mx = p0[0];
#pragma unroll
    for (int r = 1; r < 16; ++r) mx = fmaxf(mx, p0[r]);
#pragma unroll
    for (int r = 0; r < 16; ++r) mx = fmaxf(mx, p1[r]);
    mx = fmaxf(mx, __shfl_xor(mx, 32));
    const float mnew = fmaxf(st.m, mx), alpha = __builtin_amdgcn_exp2f(st.m - mnew); st.m = mnew;
    float sum = 0.f;
#pragma unroll
    for (int r = 0; r < 16; ++r) { p0[r] = __builtin_amdgcn_exp2f(p0[r] - mnew); p1[r] = __builtin_amdgcn_exp2f(p1[r] - mnew); sum += p0[r] + p1[r]; }
    st.l = st.l * alpha + sum;
#pragma unroll
    for (int r = 0; r < 16; ++r) { st.o0[r] *= alpha; st.o1[r] *= alpha; }
    bf16x8 pb[4]; pb[0] = packp(p0, 0); pb[1] = packp(p0, 1); pb[2] = packp(p1, 0); pb[3] = packp(p1, 1);
    asm volatile("" ::: "memory");
    const int blk = (lane >> 4) & 1, qq = (lane & 15) >> 2, pp = lane & 3, swz = ((qq >> 1) & 1) << 6;
#pragma unroll
    for (int s4 = 0; s4 < 4; ++s4) {
        const int rb = 16 * s4 + 4 * hq + qq;
#pragma unroll
        for (int d0 = 0; d0 < 2; ++d0) {
            const int cb = (d0 * 64 + blk * 32 + pp * 8) ^ swz;
            const s16x4 lo = vtr(vl + rb * 128 + cb), hi = vtr(vl + (rb + 8) * 128 + cb);
            const bf16x8 a = __builtin_shufflevector(lo, hi, 0, 1, 2, 3, 4, 5, 6, 7);
            if (d0 == 0) st.o0 = __builtin_amdgcn_mfma_f32_32x32x16_bf16(a, pb[s4], st.o0, 0, 0, 0);
            else st.o1 = __builtin_amdgcn_mfma_f32_32x32x16_bf16(a, pb[s4], st.o1, 0, 0, 0);
        }
    }
    asm volatile("" ::: "memory");
}
DI void finish(State& st, bf16* Orow0, const bf16* Zrow0, int lane) {
    const int r32 = lane & 31, hq = lane >> 5;
    const float lt = st.l + __shfl_xor(st.l, 32), inv = 1.0f / lt;
#pragma unroll
    for (int d0 = 0; d0 < 2; ++d0)
#pragma unroll
        for (int g = 0; g < 4; ++g) { const int d = 32 * d0 + 8 * g + 4 * hq;
            const u32x2 z = *(const GAS u32x2*)(Zrow0 + (size_t)r32 * 512 + d);
            const f32x16& o = d0 ? st.o1 : st.o0;
            const float a0 = o[4 * g] * inv * __uint_as_float(z.x << 16), a1 = o[4 * g + 1] * inv * __uint_as_float(z.x & 0xffff0000u);
            const float a2 = o[4 * g + 2] * inv * __uint_as_float(z.y << 16), a3 = o[4 * g + 3] * inv * __uint_as_float(z.y & 0xffff0000u);
            u32x2 w; w.x = cvtpk(a0, a1); w.y = cvtpk(a2, a3);
            *(GAS u32x2*)(Orow0 + (size_t)r32 * 1024 + d) = w; }
}
}

DI void p_attention(Frame& F, const CAS Args& A, int l) {
    unsigned char* ws = A.ws;
    bf16* OAB = (bf16*)(ws + WS_OAB); const bf16* KA = (const bf16*)(ws + WS_KA); const bf16* VA = (const bf16*)(ws + WS_VA); const bf16* SZA = (const bf16*)(ws + WS_SZA);
    LAS float* btab_all = (LAS float*)(F.lds + BIAS_OFF);
    for (int i = F.tid; i < AH * NREL; i += NWAVES * 64) btab_all[i] = A.in[I_RB][(size_t)l * AH * NREL + i] * LOG2E;
    __syncthreads();
    LAS unsigned char* vl = F.lds + RING_OFF + F.wave * 16384;
    const int lane = F.lane, r32 = lane & 31, hq = lane >> 5;
    constexpr int NU_P = BATCH * (SEQ / CHUNK) * 2, NU = NU_P + DECB;
    for (int u = F.vcu; u < NU; u += F.G) {
        att::State st;
#pragma unroll
        for (int r = 0; r < 16; ++r) { st.o0[r] = 0.f; st.o1[r] = 0.f; }
        st.m = -1e30f; st.l = 0.f;
        bf16x8 qr[4];
        if (u < NU_P) {
            const int b = u >> 8, c = (u & 255) >> 1, h = (u & 1) * 4 + (F.wave >> 1), hf = F.wave & 1;
            const size_t qrow0 = (size_t)b * SEQ + c * CHUNK + hf * 32;
            bf16* Qp = OAB + qrow0 * 1024 + h * 64;
#pragma unroll
            for (int ks = 0; ks < 4; ++ks) qr[ks] = att::ldfrag(Qp + (size_t)r32 * 1024 + ks * 16 + hq * 8);
            const LAS float* btab = btab_all + h * NREL;
            for (int j = (c >= 8 ? c - 8 : 0); j <= c; ++j) {
                const size_t kr0 = ((size_t)b * SEQ + j * CHUNK) * 512 + h * 64;
                att::tile<bf16>(st, qr, KA + kr0, VA + kr0, 512, 64, (c - j) * 64 + hf * 32, btab, vl, lane);
            }
            att::finish(st, Qp, SZA + qrow0 * 512 + h * 64, lane);
        } else {
            const int b = u - NU_P, h = F.wave;
            const size_t qrow0 = (size_t)MP + b * DECS;
            bf16* Qp = OAB + qrow0 * 1024 + h * 64;
#pragma unroll
            for (int ks = 0; ks < 4; ++ks) qr[ks] = att::ldfrag(Qp + (size_t)r32 * 1024 + ks * 16 + hq * 8);
            const LAS float* btab = btab_all + h * NREL;
            const float* ck = A.in[I_CK] + ((size_t)(l * DECB + b) * ATTW) * 512 + h * 64;
            const float* cv = A.in[I_CV] + ((size_t)(l * DECB + b) * ATTW) * 512 + h * 64;
            for (int j = 0; j < 8; ++j) att::tile<float>(st, qr, ck + (size_t)j * 64 * 512, cv + (size_t)j * 64 * 512, 512, 64, 512 - 64 * j, btab, vl, lane);
            att::tile<bf16>(st, qr, KA + qrow0 * 512 + h * 64, VA + qrow0 * 512 + h * 64, 512, 32, 0, btab, vl, lane);
            att::finish(st, Qp, SZA + qrow0 * 512 + h * 64, lane);
        }
    }
}

DI void p_gdn_slow(Frame& F, const CAS Args& A, int l) {
    unsigned char* ws = A.ws;
    bf16* OAB = (bf16*)(ws + WS_OAB); const bf16* XB = (const bf16*)(ws + WS_XB); const float* G = (const float*)(ws + WS_G); const float* BETA = (const float*)(ws + WS_BETA);
    int sid = -1;
    if (F.vcu < 32) { if (F.wave == 0) sid = F.vcu; } else if (F.vcu < 64) sid = 32 + (F.vcu - 32) * 8 + F.wave;
    if (sid < 0) return;
    const bool prompt = sid < 32; const int sq = prompt ? sid : sid - 32; const int b = sq >> 3, h = sq & 7, T = prompt ? SEQ : DECS;
    const size_t rowbase = prompt ? (size_t)b * SEQ : (size_t)MP + b * DECS;
    const int e = F.lane, cq = h * 64 + e, ck = 512 + cq, cv = 1024 + cq;
    const float* cw = A.in[I_CW] + (size_t)l * 4 * BQKV;
    LAS float* wl = (LAS float*)(F.lds + RING_OFF + F.wave * 16384) + 128;
#pragma unroll
    for (int i = 0; i < 4; ++i) { wl[i * 64 + e] = cw[i * BQKV + cq]; wl[(4 + i) * 64 + e] = cw[i * BQKV + ck]; wl[(8 + i) * 64 + e] = cw[i * BQKV + cv]; }
    float xq[3] = {0.f, 0.f, 0.f}, xk[3] = {0.f, 0.f, 0.f}, xv[3] = {0.f, 0.f, 0.f};
    float S[64];
#pragma unroll
    for (int d = 0; d < 64; ++d) S[d] = 0.f;
    if (!prompt) {
        const float* sc = A.in[I_SC] + ((size_t)(l * DECB + b) * 3) * BQKV;
#pragma unroll
        for (int i = 0; i < 3; ++i) { xq[i] = sc[i * BQKV + cq]; xk[i] = sc[i * BQKV + ck]; xv[i] = sc[i * BQKV + cv]; }
        const float* s0 = A.in[I_SG] + ((size_t)(l * DECB + b) * BH + h) * 4096;
#pragma unroll
        for (int d = 0; d < 64; ++d) S[d] = s0[d * 64 + e];
    }
    const float nw = A.in[I_GNW][l * 64 + e];
    const float nAexp = -expf(A.in[I_ALOG][l * 8 + h]), dtb = A.in[I_DTB][l * 8 + h];
    LAS float* kbuf = (LAS float*)(F.lds + RING_OFF + F.wave * 16384); LAS float* qbuf = kbuf + 64;
    for (int t = 0; t < T; ++t) {
        const size_t row = rowbase + t;
        const float nq = bf2f(XB[row * BQKV + cq]), nk = bf2f(XB[row * BQKV + ck]), nv = bf2f(XB[row * BQKV + cv]);
        const float aq = xq[0] * wl[e] + xq[1] * wl[64 + e] + xq[2] * wl[128 + e] + nq * wl[192 + e];
        const float ak = xk[0] * wl[256 + e] + xk[1] * wl[320 + e] + xk[2] * wl[384 + e] + nk * wl[448 + e];
        const float av = xv[0] * wl[512 + e] + xv[1] * wl[576 + e] + xv[2] * wl[640 + e] + nv * wl[704 + e];
        xq[0] = xq[1]; xq[1] = xq[2]; xq[2] = nq; xk[0] = xk[1]; xk[1] = xk[2]; xk[2] = nk; xv[0] = xv[1]; xv[1] = xv[2]; xv[2] = nv;
        const float q = aq / (1.f + expf(-aq)), k = ak / (1.f + expf(-ak)), v = av / (1.f + expf(-av));
        const float sqq = wave_sum(q * q), skk = wave_sum(k * k);
        const float qn = q * (1.0f / sqrtf(sqq + NORM_EPS)) * 0.125f, kn = k * (1.0f / sqrtf(skk + NORM_EPS));
        const float xa = G[row * 8 + h] + dtb, sp = xa > 20.f ? xa : log1pf(expf(xa));
        const float g = nAexp * sp, beta = 1.0f / (1.0f + expf(-BETA[row * 8 + h])), a = expf(g);
        asm volatile("" ::: "memory");
        kbuf[e] = kn; qbuf[e] = qn;
        asm volatile("s_waitcnt lgkmcnt(0)" ::: "memory");
        float kS = 0.f;
#pragma unroll
        for (int d = 0; d < 64; ++d) kS += kbuf[d] * S[d];
        const float coef = beta * (v - a * kS);
        float o = 0.f;
#pragma unroll
        for (int d = 0; d < 64; ++d) { S[d] = a * S[d] + kbuf[d] * coef; o += qbuf[d] * S[d]; }
        asm volatile("s_waitcnt lgkmcnt(0)" ::: "memory");
        const float ms = wave_sum(o * o) * (1.f / 64.f);
        const float on = o * (1.0f / sqrtf(ms + NORM_EPS)) * nw;
        bf16* op = OAB + row * 1024 + 512 + cq;
        *op = (bf16)f2bf(on * bf2f(*op));
    }
    float* so = A.out + (prompt ? O_GP + ((size_t)(l * BATCH + b) * BH + h) * 4096 : O_GS + ((size_t)(l * DECB + b) * BH + h) * 4096);
#pragma unroll
    for (int d = 0; d < 64; ++d) so[d * 64 + e] = S[d];
}

DI void p_inproj(Frame& F, const CAS Args& A, int l) {
    unsigned char* ws = A.ws;
    pg8::Gemm g{(const pg8::bf16_t*)(ws + WS_HB), (const pg8::bf16_t*)(ws + WS_WIN) + (size_t)l * NIN * D, M, NIN, D};
    pg8::StaticOrder S; S.init(M, NIN, F.G, F.bx);
    pg8::EpiInProj E{ws, A.out, A.in[I_ALOG] + l * 8, A.in[I_DTB] + l * 8, l};
    pg8::gemm_phase<pg8::EpiInProj, pg8::StaticOrder, true, true>(F.lds + RING_OFF, g, S, E, F.tid);
}
DI void p_mix(Frame& F, const CAS Args& A, int l) {
    unsigned char* ws = A.ws;
    pg8::Gemm g{(const pg8::bf16_t*)(ws + WS_OAB), (const pg8::bf16_t*)(ws + WS_WAB) + (size_t)l * D * 1024, M, D, 1024};
    pg8::StaticOrder S; S.init(M, D, F.G, F.bx);
    pg8::EpiMix E{ws};
    pg8::gemm_phase<pg8::EpiMix, pg8::StaticOrder, true, true>(F.lds + RING_OFF, g, S, E, F.tid);
}
DI void p_outproj(Frame& F, const CAS Args& A, int l) {
    unsigned char* ws = A.ws;
    pg8::Gemm g{(const pg8::bf16_t*)(ws + WS_MIX), (const pg8::bf16_t*)(ws + WS_WO) + (size_t)l * D * D, M, D, D};
    pg8::StaticOrder S; S.init(M, D, F.G, F.bx);
    pg8::EpiResid E{A.out + O_Y, (float*)(ws + WS_Z)};
    pg8::gemm_phase<pg8::EpiResid, pg8::StaticOrder, true, true>(F.lds + RING_OFF, g, S, E, F.tid);
}
DI void p_ln(Frame& F, const CAS Args& A, int l) {
    unsigned char* ws = A.ws;
    const float* Z = (const float*)(ws + WS_Z); float* H = A.out + O_Y; bf16* HB = (bf16*)(ws + WS_HB);
    const int gw = F.vcu * NWAVES + F.wave, NGW = F.G * NWAVES;
    for (int m = gw; m < M; m += NGW) ln_row(Z + (size_t)m * D, A.in[I_LNG] + (size_t)l * D, A.in[I_LNB] + (size_t)l * D, H + (size_t)m * D, HB + (size_t)m * D, F.lane);
}

#ifndef PH_MASK
#define PH_MASK 0xff
#endif
constexpr int PH_PER_LAYER = 7, N_PHASES = 1 + DEPTH * PH_PER_LAYER;
template <int PMASK> __global__ void __launch_bounds__(NWAVES * 64, 2) trunk_fwd(Args args_) {
    const Args& args = args_;
    extern __shared__ __attribute__((aligned(16))) unsigned char lds[];
    LAS unsigned char* const ldsb = (LAS unsigned char*)lds;
    for (int u = threadIdx.x; u < (BIAS_OFF - LDSCTL_OFF) / 4; u += NWAVES * 64) ((LAS unsigned*)(ldsb + LDSCTL_OFF))[u] = 0u;
    __syncthreads();
    const int lo = args.ph_lo, hi = args.ph_hi;
    const int wave_s = __builtin_amdgcn_readfirstlane(threadIdx.x >> 6);
    if (hi - lo > 1) (void)xcd_barrier_post((unsigned*)((gu32*)(args.ws + WS_CTL) + CW_BAR), (volatile LAS unsigned*)(ldsb + MISC_OFF) + 8);
#define PH_BEGIN(k) if (lo <= (k) && (k) < hi) { \
        const CAS Args* kp = (const CAS Args*)__builtin_amdgcn_kernarg_segment_ptr(); asm volatile("" : "+s"(kp)); const CAS Args& A_ = *kp; \
        int tid = wave_s * 64 + (int)__builtin_amdgcn_mbcnt_hi(~0u, __builtin_amdgcn_mbcnt_lo(~0u, 0u)), bx = blockIdx.x; asm volatile("" : "+v"(tid)); asm volatile("" : "+s"(bx)); \
        Frame F; F.lds = ldsb; F.MISC = (volatile LAS unsigned*)(ldsb + MISC_OFF); F.tid = tid; F.lane = tid & 63; F.wave = __builtin_amdgcn_readfirstlane(tid >> 6); \
        F.G = gridDim.x; F.vcu = (F.G % 8 == 0) ? (bx % 8) * (F.G / 8) + bx / 8 : bx; F.bx = bx; F.ctl = (gu32*)(A_.ws + WS_CTL);
#define PH_END(k) if ((k) + 1 < hi) { XcdBarrier bar; bar.bar = (unsigned*)((gu32*)(A_.ws + WS_CTL) + CW_BAR); bar.x = xb_xcc_id(); bar.st = (volatile LAS unsigned*)(ldsb + MISC_OFF) + 8; xcd_barrier(bar, F.tid == 0); } }
#define RUN_LAYER(l) \
    PH_BEGIN(1 + 7 * (l) + 0) if constexpr ((PMASK & 2) != 0) p_inproj(F, A_, (l)); PH_END(1 + 7 * (l) + 0) \
    PH_BEGIN(1 + 7 * (l) + 1) if constexpr ((PMASK & 4) != 0) p_attention(F, A_, (l)); PH_END(1 + 7 * (l) + 1) \
    PH_BEGIN(1 + 7 * (l) + 3) if constexpr ((PMASK & 16) != 0) p_gdn_slow(F, A_, (l)); PH_END(1 + 7 * (l) + 3) \
    PH_BEGIN(1 + 7 * (l) + 4) if constexpr ((PMASK & 32) != 0) p_mix(F, A_, (l)); PH_END(1 + 7 * (l) + 4) \
    PH_BEGIN(1 + 7 * (l) + 5) if constexpr ((PMASK & 64) != 0) p_outproj(F, A_, (l)); PH_END(1 + 7 * (l) + 5) \
    PH_BEGIN(1 + 7 * (l) + 6) if constexpr ((PMASK & 128) != 0) p_ln(F, A_, (l)); PH_END(1 + 7 * (l) + 6)
    PH_BEGIN(0) if constexpr ((PMASK & 1) != 0) p0_prologue(F, A_); PH_END(0)
    RUN_LAYER(0)
    RUN_LAYER(1)
#undef PH_BEGIN
#undef PH_END
#undef RUN_LAYER
}

extern "C" void kernel_launch(void* const* d_in, const int* in_sizes, int n_in, void* d_out, int out_size, void* d_ws, size_t ws_size, hipStream_t stream) {
    static int grid = 0;
    if (grid == 0) {
        if (n_in != 19 || in_sizes[0] != MP * D || (size_t)out_size != O_END || ws_size < WS_END) {
            fprintf(stderr, "kernel_launch: unexpected shapes: n_in %d in0 %d out %d ws %zu (need %zu); nothing launched\n", n_in, n_in > 0 ? in_sizes[0] : -1, out_size, ws_size, (size_t)WS_END); grid = -1; return; }
        int dev = 0, cus = 0, per_cu = 0;
        if (hipGetDevice(&dev) != hipSuccess || hipDeviceGetAttribute(&cus, hipDeviceAttributeMultiprocessorCount, dev) != hipSuccess) { grid = -1; return; }
        bool okattr = true;
#define SETATTR(MK) okattr = okattr && (hipFuncSetAttribute((const void*)trunk_fwd<MK>, hipFuncAttributeMaxDynamicSharedMemorySize, LDS_BYTES) == hipSuccess)
#if MK_PER_PHASE
        SETATTR(1); SETATTR(2); SETATTR(4); SETATTR(16); SETATTR(32); SETATTR(64); SETATTR(128);
#else
        SETATTR(0xff);
#endif
        if (!okattr) { fprintf(stderr, "kernel_launch: hipFuncSetAttribute failed\n"); grid = -1; return; }
        (void)per_cu; (void)hipGetLastError();
        grid = cus;
    }
    if (grid < 0) return;
    if (hipMemsetAsync((char*)d_ws + WS_CTL, 0, CTL_ZERO_BYTES, stream) != hipSuccess) return;
    Args a{};
    for (int i = 0; i < 19; ++i) a.in[i] = (const float*)d_in[i];
    a.out = (float*)d_out; a.ws = (unsigned char*)d_ws;
#if MK_PER_PHASE
    for (int ph = 0; ph < N_PHASES; ++ph) {
        const int s = ph == 0 ? -1 : (ph - 1) % PH_PER_LAYER;
        if (s == 2) continue;
        a.ph_lo = ph; a.ph_hi = ph + 1; a.li = 0;
        const dim3 g(grid), b(NWAVES * 64);
        if (s == -1) hipLaunchKernelGGL(trunk_fwd<1>, g, b, LDS_BYTES, stream, a);
        else if (s == 0) hipLaunchKernelGGL(trunk_fwd<2>, g, b, LDS_BYTES, stream, a);
        else if (s == 1) hipLaunchKernelGGL(trunk_fwd<4>, g, b, LDS_BYTES, stream, a);
        else if (s == 3) hipLaunchKernelGGL(trunk_fwd<16>, g, b, LDS_BYTES, stream, a);
        else if (s == 4) hipLaunchKernelGGL(trunk_fwd<32>, g, b, LDS_BYTES, stream, a);
        else if (s == 5) hipLaunchKernelGGL(trunk_fwd<64>, g, b, LDS_BYTES, stream, a);
        else hipLaunchKernelGGL(trunk_fwd<128>, g, b, LDS_BYTES, stream, a);
    }
#else
    a.ph_lo = 0; a.ph_hi = N_PHASES; a.li = 0;
    hipLaunchKernelGGL(trunk_fwd<0xff>, dim3(grid), dim3(NWAVES * 64), LDS_BYTES, stream, a);
#endif
}
```

```cpp
#include <hip/hip_runtime.h>
#include <cstdio>
#include <cstdint>

#ifndef MK_PER_PHASE
#define MK_PER_PHASE 0
#endif

constexpr int D = 1024, BATCH = 4, SEQ = 8192, DEPTH = 2, DECB = 32, DECS = 32, PAST = 4096;
constexpr int MP = BATCH * SEQ, MS = DECB * DECS, M = MP + MS;
constexpr int CHUNK = 64, ATTW = 512, AH = 8, AD = 64, AW = 512, NREL = 192, RELMAX = 128;
constexpr int BH = 8, BD = 64, BW = 512, BQKV = 1536;
constexpr int IN_DIM = 6160, NIN = 6400;
constexpr float LN_EPS = 1e-5f, NORM_EPS = 1e-6f;
constexpr float ALPHA = 1.41421356237309515f;
constexpr float LOG2E = 1.4426950408889634f;
constexpr float QSCALE = 0.125f * LOG2E;

constexpr size_t O_Y = 0;
constexpr size_t O_KP = (size_t)M * D;
constexpr size_t O_VP = O_KP + (size_t)DEPTH * BATCH * ATTW * AW;
constexpr size_t O_CP = O_VP + (size_t)DEPTH * BATCH * ATTW * AW;
constexpr size_t O_GP = O_CP + (size_t)DEPTH * BATCH * 3 * BQKV;
constexpr size_t O_KS = O_GP + (size_t)DEPTH * BATCH * BH * BD * BD;
constexpr size_t O_VS = O_KS + (size_t)DEPTH * DECB * DECS * AW;
constexpr size_t O_CS = O_VS + (size_t)DEPTH * DECB * DECS * AW;
constexpr size_t O_GS = O_CS + (size_t)DEPTH * DECB * 3 * BQKV;
constexpr size_t O_END = O_GS + (size_t)DEPTH * DECB * BH * BD * BD;
static_assert(O_END == 43585536, "output size");

constexpr size_t MiB = 1u << 20;
constexpr size_t WS_CTL = 0, CTL_ZERO_BYTES = 1 * MiB;
constexpr size_t WS_WIN = 1 * MiB;
constexpr size_t WS_WAB = 26 * MiB;
constexpr size_t WS_WO = 30 * MiB;
constexpr size_t WS_G = 34 * MiB;
constexpr size_t WS_BETA = WS_G + (size_t)M * 8 * 4;
constexpr size_t WS_HB = 37 * MiB;
constexpr size_t WS_KA = 103 * MiB, WS_VA = 136 * MiB, WS_SZA = 169 * MiB;
constexpr size_t WS_OAB = 202 * MiB;
constexpr size_t WS_XB = 268 * MiB;
constexpr size_t WS_GA = 367 * MiB, WS_GB = 433 * MiB;
constexpr size_t WS_HALO = 499 * MiB;
constexpr size_t WS_END = 504 * MiB;
constexpr size_t WS_MIX = WS_HB;
constexpr size_t WS_Z = WS_GA;
constexpr int GD_UNITS = BATCH * BH * (SEQ / CHUNK) + DECB * BH;
constexpr size_t GD_MAT = (size_t)GD_UNITS * 8192;
constexpr size_t WS_GAO = 37 * MiB, WS_GBS = WS_GAO + GD_MAT, WS_GCO = WS_GBS + GD_MAT, WS_GCS = WS_GCO + GD_MAT, WS_GE = WS_GCS + GD_MAT;
static_assert(WS_GE + (size_t)GD_UNITS * 4 <= WS_OAB, "delta-rule operators overlay");
static_assert(WS_HALO + (size_t)(MP / 64) * 3 * BQKV * 2 <= WS_END, "halo");
static_assert(WS_BETA + (size_t)M * 8 * 4 <= WS_HB && WS_HB + (size_t)M * D * 2 <= WS_KA && WS_SZA + (size_t)M * 512 * 2 <= WS_OAB, "ws map");
static_assert(WS_OAB + (size_t)M * D * 2 <= WS_XB && WS_XB + (size_t)M * BQKV * 2 <= WS_GA && WS_GB + (size_t)M * D * 2 <= WS_HALO, "ws map 2");
static_assert(WS_Z + (size_t)M * D * 4 <= WS_HALO, "ws map 3");
constexpr int CW_TMO = 0, CW_CODE = 1, CW_BAR = 4096;

constexpr int RING_OFF = 0, RING_BYTES = 131072;
constexpr int PW_BYTES = 18432;
constexpr int LDSCTL_OFF = 8 * PW_BYTES, MISC_OFF = LDSCTL_OFF + 320;
constexpr int BIAS_OFF = LDSCTL_OFF + 1024;
constexpr int LDS_BYTES = 163840;
static_assert(BIAS_OFF + AH * NREL * 4 <= LDS_BYTES && MISC_OFF + 128 <= BIAS_OFF && RING_BYTES <= LDSCTL_OFF, "LDS map");
constexpr int NWAVES = 8;

namespace pg8 {
#define PG8_LAS __attribute__((address_space(3)))
typedef unsigned short bf16_t;
typedef short bf16x8 __attribute__((ext_vector_type(8)));
typedef float f32x4 __attribute__((ext_vector_type(4)));
typedef unsigned u32x4 __attribute__((ext_vector_type(4)));
constexpr int BM = 256, BK = 64, HALF = 128, HTB = HALF * BK * 2  , STAGE_BYTES = 8 * HTB, NXCD = 8, WGM = 8;

__host__ __device__ __forceinline__ int lds_byte(int r, int c) { const int st = (r >> 4) * 2 + (c >> 5), rr = r & 15, cc = c & 31, ob = rr * 64 + cc * 2; return st * 1024 + (ob ^ (((ob >> 9) & 1) << 5)); }
__host__ __device__ __forceinline__ void stage_rc(int b, int& R, int& C) { const int st = b / 1024, sb = b % 1024, swz = sb ^ (((sb >> 9) & 1) << 5); R = (st >> 1) * 16 + swz / 64; C = (st & 1) * 32 + (swz % 64) / 2; }
__host__ __device__ __forceinline__ int perm32(int rho) { const int n = rho >> 4, i = rho & 15; return 8 * (i >> 2) + 4 * n + (i & 3); }

struct Unit { int pm, pn; };
struct Gemm { const bf16_t* A; const bf16_t* Bt; int M, N, K; };

struct StaticOrder {
    int nM, nN, nwg, G, c;
    __host__ __device__ void init(int M, int N, int G_, int c_) { nM = M / BM; nN = N / BM; nwg = nM * nN; G = G_; c = c_; }
    __host__ __device__ bool next(int i, Unit& u) const {
        const long L = (long)i * G + c; if (L >= nwg) return false;
        int wgid = (int)L; { const int q = nwg / NXCD, r = nwg % NXCD, xcd = wgid % NXCD, off = wgid / NXCD; wgid = (xcd < r ? xcd * (q + 1) : r * (q + 1) + (xcd - r) * q) + off; }
        const int nig = WGM * nN, gid = wgid / nig, fm = gid * WGM, gsz = (nM - fm) < WGM ? (nM - fm) : WGM;
        u.pm = fm + ((wgid % nig) % gsz); u.pn = (wgid % nig) / gsz; return true;
    }
    __device__ __forceinline__ void a_ready(const Unit&) const {}
    __device__ __forceinline__ void done(const Unit&) const {}
};


__device__ __forceinline__ unsigned cvt_pk_bf16(float lo, float hi) { unsigned r; asm volatile("v_cvt_pk_bf16_f32 %0, %1, %2" : "=v"(r) : "v"(lo), "v"(hi)); return r; }
__device__ __forceinline__ float bf_lo(unsigned w) { return __uint_as_float(w << 16); }
__device__ __forceinline__ float bf_hi(unsigned w) { return __uint_as_float(w & 0xffff0000u); }
__device__ __forceinline__ float sigmoid_f(float x) { return __builtin_amdgcn_rcpf(1.0f + __expf(-x)); }
__device__ __forceinline__ float silu_f(float x) { return x * sigmoid_f(x); }
__device__ __forceinline__ u32x4 pack8(const f32x4& a, const f32x4& b) { u32x4 w; w.x = cvt_pk_bf16(a[0], a[1]); w.y = cvt_pk_bf16(a[2], a[3]); w.z = cvt_pk_bf16(b[0], b[1]); w.w = cvt_pk_bf16(b[2], b[3]); return w; }

template <int ACT  > __device__ __forceinline__ void epi_store_bf16(const f32x4 (&acc)[2][2][4][2], unsigned char* base, unsigned off0, unsigned ldb  , float scale) {
#pragma unroll
    for (int ai = 0; ai < 2; ++ai)
#pragma unroll
        for (int m = 0; m < 4; ++m) {
#pragma unroll
            for (int bj = 0; bj < 2; ++bj) {
                f32x4 v0 = acc[ai][bj][m][0], v1 = acc[ai][bj][m][1];
                if (ACT == 0) { v0 = v0 * scale; v1 = v1 * scale; }
                if (ACT == 1) {
#pragma unroll
                    for (int j = 0; j < 4; ++j) { v0[j] = silu_f(v0[j]); v1[j] = silu_f(v1[j]); } }
                if (ACT == 2) {
#pragma unroll
                    for (int j = 0; j < 4; ++j) { v0[j] = sigmoid_f(v0[j]); v1[j] = sigmoid_f(v1[j]); } }
                *(u32x4*)(base + (off0 + (unsigned)(ai * HALF + m * 16) * ldb + (unsigned)(bj * HALF * 2))) = pack8(v0, v1);
            }
            asm volatile("" ::: "memory");
        }
}
__device__ __forceinline__ void epi_store_f32_rows(const f32x4 (&acc)[2][2][4][2], unsigned char* base, unsigned off0, unsigned ldb, int rt0, int r_lo, int r_hi) {
#pragma unroll
    for (int ai = 0; ai < 2; ++ai)
#pragma unroll
        for (int m = 0; m < 4; ++m) {
            const int rt = rt0 + ai * HALF + m * 16;
            if (rt >= r_lo && rt < r_hi) {
#pragma unroll
                for (int bj = 0; bj < 2; ++bj) {
                    unsigned char* p = base + (off0 + (unsigned)(ai * HALF + m * 16) * ldb + (unsigned)(bj * HALF * 4));
                    *(f32x4*)p = acc[ai][bj][m][0]; *(f32x4*)(p + 16) = acc[ai][bj][m][1];
                }
            }
            asm volatile("" ::: "memory");
        }
}
struct EpiInProj {
    static constexpr bool PERM = true, AFTER_DRAIN = false; static constexpr int MIDK = 0;
    unsigned char* ws; float* out; const float* a_log; const float* dt_bias; int l;
    __device__ __forceinline__ void operator()(const f32x4 (&acc)[2][2][4][2], const Unit& u, int wr, int wc, int fr, int fq) const {
        const int pn = u.pn, pm = u.pm;
        const int rt0 = wr * 64 + fr;
        const int ct0 = wc * 32 + 8 * fq;
        const unsigned row0 = (unsigned)pm * BM + rt0;
        if (pn < 2) {
            epi_store_bf16<0>(acc, ws + WS_OAB, (row0 * 1024u + pn * 256 + ct0) * 2u, 2048u, QSCALE);
        } else if (pn < 6) {
            const int isv = (pn >= 4); const unsigned col = (unsigned)(pn - (isv ? 4 : 2)) * 256 + ct0;
            epi_store_bf16<0>(acc, ws + (isv ? WS_VA : WS_KA), (row0 * 512u + col) * 2u, 1024u, 1.0f);
            if (pm >= 128) {
                unsigned char* ob = (unsigned char*)(out + (isv ? O_VS : O_KS) + (size_t)l * DECB * DECS * AW);
                epi_store_f32_rows(acc, ob, ((row0 - MP) * 512u + col) * 4u, 2048u, rt0, 0, 256);
            } else if ((pm & 31) >= 30) {
                unsigned char* ob = (unsigned char*)(out + (isv ? O_VP : O_KP) + (size_t)l * BATCH * ATTW * AW);
                epi_store_f32_rows(acc, ob, ((((unsigned)(pm >> 5) * ATTW + ((pm & 31) - 30) * 256 + rt0) * 512u) + col) * 4u, 2048u, rt0, 0, 256);
            }
        } else if (pn < 8) {
            epi_store_bf16<1>(acc, ws + WS_SZA, (row0 * 512u + (pn - 6) * 256 + ct0) * 2u, 1024u, 1.0f);
        } else if (pn < 14) {
            const unsigned col = (unsigned)(pn - 8) * 256 + ct0;
            epi_store_bf16<0>(acc, ws + WS_XB, (row0 * (unsigned)BQKV + col) * 2u, BQKV * 2u, 1.0f);
            if (pm >= 128) {
                float* oCs = out + O_CS + (size_t)l * DECB * 3 * BQKV;
#pragma unroll
                for (int ai = 0; ai < 2; ++ai)
#pragma unroll
                    for (int m = 0; m < 4; ++m) { const int rs = (int)(row0 - MP) + ai * HALF + m * 16, t = rs & 31;
                        if (t >= 29) {
#pragma unroll
                            for (int bj = 0; bj < 2; ++bj) { float* o = oCs + ((size_t)(rs >> 5) * 3 + (t - 29)) * BQKV + col + bj * HALF; *(f32x4*)o = acc[ai][bj][m][0]; *(f32x4*)(o + 4) = acc[ai][bj][m][1]; } }
                        asm volatile("" ::: "memory"); }
            } else {
#pragma unroll
                for (int ai = 0; ai < 2; ++ai)
#pragma unroll
                    for (int m = 0; m < 4; ++m) { const int rr = (int)row0 + ai * HALF + m * 16, t = rr & 63;
                        if (t >= 61) {
#pragma unroll
                            for (int bj = 0; bj < 2; ++bj) *(u32x4*)(ws + WS_HALO + ((size_t)((rr >> 6) * 3 + (t - 61)) * BQKV + col + bj * HALF) * 2) = pack8(acc[ai][bj][m][0], acc[ai][bj][m][1]); }
                        asm volatile("" ::: "memory"); }
                if ((pm & 31) == 31) {
                    unsigned char* ob = (unsigned char*)(out + O_CP + (size_t)l * BATCH * 3 * BQKV);
                    epi_store_f32_rows(acc, ob, ((((unsigned)(pm >> 5) * 3 + (unsigned)(rt0 - 253)) * BQKV) + col) * 4u, BQKV * 4u, rt0, 253, 256);
                }
            }
        } else if (pn < 16) {
            epi_store_bf16<1>(acc, ws + WS_OAB, (row0 * 1024u + 512 + (pn - 14) * 256 + ct0) * 2u, 2048u, 1.0f);
        } else if (pn < 24) {
            epi_store_bf16<2>(acc, ws + (pn < 20 ? WS_GA : WS_GB), (row0 * 1024u + ((pn - 16) & 3) * 256 + ct0) * 2u, 2048u, 1.0f);
        } else {
            if (wc == 0 && fq < 2) {
                float* G = (float*)(ws + WS_G); float* BETA = (float*)(ws + WS_BETA);
#pragma unroll
                for (int ai = 0; ai < 2; ++ai)
#pragma unroll
                    for (int m = 0; m < 4; ++m) {
                        const size_t row = (size_t)row0 + ai * HALF + m * 16;
                        f32x4 v0 = acc[ai][0][m][0], v1 = acc[ai][0][m][1];
                        float* dst = (fq == 0 ? G : BETA) + row * 8;
                        *(f32x4*)dst = v0; *(f32x4*)(dst + 4) = v1;
                        asm volatile("" ::: "memory");
                    }
            }
        }
    }
};

struct EpiMix {
    static constexpr bool PERM = true, AFTER_DRAIN = false; static constexpr int MIDK = 8;
    unsigned char* ws;
    __device__ __forceinline__ void mid(f32x4 (&acc)[2][2][4][2], const Unit& u, int wr, int wc, int fr, int fq) const {
        unsigned off0 = (((unsigned)u.pm * BM + wr * 64 + fr) * 1024u + u.pn * BM + wc * 32 + 8 * fq) * 2u;
        asm volatile("" : "+v"(off0));
        const unsigned char* GA = ws + WS_GA; const unsigned char* GB = ws + WS_GB;
#pragma unroll
        for (int ai = 0; ai < 2; ++ai)
#pragma unroll
            for (int m = 0; m < 4; ++m) {
#pragma unroll
                for (int bj = 0; bj < 2; ++bj) {
                    const unsigned off = off0 + (unsigned)(ai * HALF + m * 16) * 2048u + (unsigned)(bj * HALF * 2);
                    const u32x4 a = *(const u32x4*)(GA + off), b = *(const u32x4*)(GB + off);
                    f32x4 r0, r1;
                    r0[0] = bf_lo(a.x) * __builtin_amdgcn_rcpf(bf_lo(b.x)); r0[1] = bf_hi(a.x) * __builtin_amdgcn_rcpf(bf_hi(b.x));
                    r0[2] = bf_lo(a.y) * __builtin_amdgcn_rcpf(bf_lo(b.y)); r0[3] = bf_hi(a.y) * __builtin_amdgcn_rcpf(bf_hi(b.y));
                    r1[0] = bf_lo(a.z) * __builtin_amdgcn_rcpf(bf_lo(b.z)); r1[1] = bf_hi(a.z) * __builtin_amdgcn_rcpf(bf_hi(b.z));
                    r1[2] = bf_lo(a.w) * __builtin_amdgcn_rcpf(bf_lo(b.w)); r1[3] = bf_hi(a.w) * __builtin_amdgcn_rcpf(bf_hi(b.w));
                    acc[ai][bj][m][0] = acc[ai][bj][m][0] * r0; acc[ai][bj][m][1] = acc[ai][bj][m][1] * r1;
                }
                asm volatile("" ::: "memory");
            }
    }
    __device__ __forceinline__ void operator()(const f32x4 (&acc)[2][2][4][2], const Unit& u, int wr, int wc, int fr, int fq) const {
        const unsigned off0 = (((unsigned)u.pm * BM + wr * 64 + fr) * 1024u + u.pn * BM + wc * 32 + 8 * fq) * 2u;
        const unsigned char* GB = ws + WS_GB; unsigned char* MIX = ws + WS_MIX;
#pragma unroll
        for (int ai = 0; ai < 2; ++ai)
#pragma unroll
            for (int m = 0; m < 4; ++m) {
#pragma unroll
                for (int bj = 0; bj < 2; ++bj) {
                    const unsigned off = off0 + (unsigned)(ai * HALF + m * 16) * 2048u + (unsigned)(bj * HALF * 2);
                    const u32x4 b = *(const u32x4*)(GB + off);
                    f32x4 v0 = acc[ai][bj][m][0], v1 = acc[ai][bj][m][1];
                    v0[0] *= bf_lo(b.x); v0[1] *= bf_hi(b.x); v0[2] *= bf_lo(b.y); v0[3] *= bf_hi(b.y);
                    v1[0] *= bf_lo(b.z); v1[1] *= bf_hi(b.z); v1[2] *= bf_lo(b.w); v1[3] *= bf_hi(b.w);
                    *(u32x4*)(MIX + off) = pack8(v0, v1);
                }
                asm volatile("" ::: "memory");
            }
    }
};

struct EpiResid {
    static constexpr bool PERM = false, AFTER_DRAIN = false; static constexpr int MIDK = 0;
    const float* H; float* Z;
    __device__ __forceinline__ void operator()(const f32x4 (&acc)[2][2][4][2], const Unit& u, int wr, int wc, int fr, int fq) const {
        const int row0 = u.pm * BM + wr * 64 + fr, col0 = u.pn * BM + wc * 32 + 4 * fq;
#pragma unroll
        for (int ai = 0; ai < 2; ++ai)
#pragma unroll
            for (int m = 0; m < 4; ++m) { const size_t off = (size_t)(row0 + ai * HALF + m * 16) * D + col0;
#pragma unroll
                for (int bj = 0; bj < 2; ++bj)
#pragma unroll
                    for (int n = 0; n < 2; ++n) { const f32x4 h = *(const f32x4*)(H + off + bj * HALF + n * 16); *(f32x4*)(Z + off + bj * HALF + n * 16) = h * ALPHA + acc[ai][bj][m][n]; } }
    }
};

template <class Epi, class Sched, bool ALIGN_EPI = false, bool SP2 = false>
__device__ __forceinline__ void gemm_phase(PG8_LAS unsigned char* lds, const Gemm g, const Sched& S, const Epi& E, const int tid_in) {
    const int tid = tid_in, wid = __builtin_amdgcn_readfirstlane(tid >> 6), lane = tid & 63, wr = wid >> 2, wc = wid & 3, fr = lane & 15, fq = lane >> 4;
    const int K = g.K, nt = K / BK;
    unsigned voffA[2], voffB[2];
#pragma unroll
    for (int i = 0; i < 2; ++i) { int R, C; stage_rc(tid * 16 + i * 8192, R, C); const int Rb = Epi::PERM ? ((R & ~31) + perm32(R & 31)) : R;
        voffA[i] = (unsigned)(R * K + C) * 2u; voffB[i] = (unsigned)(Rb * K + C) * 2u; }
    const size_t kstep = (size_t)(BK * 2);
    const size_t hstep = (size_t)HALF * K * 2;
    const size_t tstep = 2 * hstep;
    const unsigned ldsw = (unsigned)wid * 1024u;
    const int aoff = lds_byte(wr * 64 + fr, fq * 8), boff = lds_byte(wc * 32 + fr, fq * 8);
#define PG8_SA(b, h) (((b) * 2 + (h)) * HTB)
#define PG8_SB(b, h) ((4 + (b) * 2 + (h)) * HTB)
#define PG8_STAGE(bufoff, gbase, voff) do { _Pragma("unroll") for (int _i = 0; _i < 2; ++_i) \
        __builtin_amdgcn_global_load_lds((const unsigned*)((const char*)(gbase) + (voff)[_i]), (PG8_LAS unsigned*)(lds + (bufoff) + ldsw + _i * 8192), 16, 0, 0); } while (0)
#define PG8_LDA(dst, b, h) do { _Pragma("unroll") for (int m = 0; m < 4; ++m) _Pragma("unroll") for (int k = 0; k < 2; ++k) dst[m][k] = *(const PG8_LAS bf16x8*)(lds + PG8_SA(b, h) + aoff + m * 2048 + k * 1024); } while (0)
#define PG8_LDB(dst, b, h) do { _Pragma("unroll") for (int n = 0; n < 2; ++n) _Pragma("unroll") for (int k = 0; k < 2; ++k) dst[n][k] = *(const PG8_LAS bf16x8*)(lds + PG8_SB(b, h) + boff + n * 2048 + k * 1024); } while (0)
#define PG8_MMA(ai, bj, At, Bt) do { __builtin_amdgcn_s_setprio(1); _Pragma("unroll") for (int m = 0; m < 4; ++m) _Pragma("unroll") for (int n = 0; n < 2; ++n) _Pragma("unroll") for (int k = 0; k < 2; ++k) \
        acc[ai][bj][m][n] = __builtin_amdgcn_mfma_f32_16x16x32_bf16(Bt[n][k], At[m][k], acc[ai][bj][m][n], 0, 0, 0); __builtin_amdgcn_s_setprio(0); } while (0)
#define PG8_WAIT_V(n) asm volatile("s_waitcnt vmcnt(" #n ")" ::: "memory")
#define PG8_WAIT_L(n) asm volatile("s_waitcnt lgkmcnt(" #n ")" ::: "memory")
#define PG8_BAR __builtin_amdgcn_s_barrier()
#define PG8_SCHED __builtin_amdgcn_sched_barrier(0)
    Unit cur, nxt; int ui = 0;
    if (!S.next(0, cur)) return;
    f32x4 acc[2][2][4][2];
#pragma unroll
    for (int a = 0; a < 2; ++a)
#pragma unroll
        for (int b = 0; b < 2; ++b)
#pragma unroll
            for (int m = 0; m < 4; ++m)
#pragma unroll
                for (int n = 0; n < 2; ++n) acc[a][b][m][n] = (f32x4){0.f, 0.f, 0.f, 0.f};
    bf16x8 At[4][2], B0[2][2], B1[2][2];
    const char* cA = (const char*)g.A + (size_t)cur.pm * tstep; const char* cB = (const char*)g.Bt + (size_t)cur.pn * tstep;
    S.a_ready(cur);
    if constexpr (SP2) {
        PG8_STAGE(PG8_SB(0, 0), cB, voffB); PG8_STAGE(PG8_SB(0, 1), cB + hstep, voffB); PG8_STAGE(PG8_SA(0, 0), cA, voffA); PG8_STAGE(PG8_SA(0, 1), cA + hstep, voffA);
        if (wr == 1) PG8_BAR;
        PG8_WAIT_V(2); PG8_BAR;
        PG8_STAGE(PG8_SB(1, 0), cB + kstep, voffB); PG8_STAGE(PG8_SA(1, 0), cA + kstep, voffA); PG8_STAGE(PG8_SB(1, 1), cB + hstep + kstep, voffB);
        PG8_WAIT_V(6); PG8_BAR;
    } else {
        PG8_STAGE(PG8_SB(0, 0), cB, voffB); PG8_STAGE(PG8_SA(0, 0), cA, voffA); PG8_STAGE(PG8_SB(0, 1), cB + hstep, voffB); PG8_STAGE(PG8_SA(0, 1), cA + hstep, voffA);
        if (wr == 1) PG8_BAR;
        PG8_WAIT_V(4); PG8_BAR;
        PG8_STAGE(PG8_SB(1, 0), cB + kstep, voffB); PG8_STAGE(PG8_SA(1, 0), cA + kstep, voffA); PG8_STAGE(PG8_SB(1, 1), cB + hstep + kstep, voffB);
        PG8_WAIT_V(6); PG8_BAR;
    }
    for (;;) {
        const bool has_next = S.next(ui + 1, nxt);
        const char* nA = has_next ? (const char*)g.A + (size_t)nxt.pm * tstep : cA; const char* nB = has_next ? (const char*)g.Bt + (size_t)nxt.pn * tstep : cB;
        for (int t = 0; t < nt; t += 2) {
            if constexpr (Epi::MIDK > 0) { if (t == Epi::MIDK) E.mid(acc, cur, wr, wc, fr, fq); }
            const bool last = (t == nt - 2);
            const char* a1 = cA + (size_t)(t + 1) * kstep;
            const char* a2 = last ? nA : cA + (size_t)(t + 2) * kstep; const char* b2 = last ? nB : cB + (size_t)(t + 2) * kstep;
            const char* a3 = a2 + kstep; const char* b3 = b2 + kstep;
            if (last && has_next) S.a_ready(nxt);
            if constexpr (SP2) {
            PG8_LDB(B0, 0, 0); PG8_LDB(B1, 0, 1); PG8_SCHED; PG8_LDA(At, 0, 0); PG8_STAGE(PG8_SA(1, 1), a1 + hstep, voffA);
            PG8_WAIT_V(8); PG8_WAIT_L(0); PG8_BAR; PG8_MMA(0, 0, At, B0); PG8_MMA(0, 1, At, B1); PG8_BAR; PG8_SCHED;
            PG8_LDA(At, 0, 1); PG8_STAGE(PG8_SB(0, 0), b2, voffB); PG8_STAGE(PG8_SB(0, 1), b2 + hstep, voffB); PG8_STAGE(PG8_SA(0, 0), a2, voffA);
            PG8_WAIT_V(8); PG8_WAIT_L(0); PG8_BAR; PG8_MMA(1, 0, At, B0); PG8_MMA(1, 1, At, B1); PG8_BAR; PG8_SCHED;
            PG8_LDB(B0, 1, 0); PG8_LDB(B1, 1, 1); PG8_SCHED; PG8_LDA(At, 1, 0); PG8_STAGE(PG8_SA(0, 1), a2 + hstep, voffA);
            PG8_WAIT_V(8); PG8_WAIT_L(0); PG8_BAR; PG8_MMA(0, 0, At, B0); PG8_MMA(0, 1, At, B1); PG8_BAR; PG8_SCHED;
            PG8_LDA(At, 1, 1); PG8_STAGE(PG8_SB(1, 0), b3, voffB); PG8_STAGE(PG8_SB(1, 1), b3 + hstep, voffB); PG8_STAGE(PG8_SA(1, 0), a3, voffA);
            PG8_WAIT_V(8); PG8_WAIT_L(0); PG8_BAR; PG8_MMA(1, 0, At, B0); PG8_MMA(1, 1, At, B1); PG8_BAR; PG8_SCHED;
            } else {
            PG8_LDB(B0, 0, 0); PG8_SCHED; PG8_LDA(At, 0, 0); PG8_STAGE(PG8_SA(1, 1), a1 + hstep, voffA);
            PG8_WAIT_L(8); PG8_BAR; PG8_WAIT_L(0); PG8_MMA(0, 0, At, B0); PG8_BAR; PG8_SCHED;
            PG8_LDB(B1, 0, 1); PG8_STAGE(PG8_SB(0, 0), b2, voffB);
            PG8_BAR; PG8_WAIT_L(0); PG8_MMA(0, 1, At, B1); PG8_BAR;
            PG8_LDA(At, 0, 1); PG8_STAGE(PG8_SA(0, 0), a2, voffA);
            PG8_BAR; PG8_WAIT_L(0); PG8_MMA(1, 0, At, B0); PG8_BAR; PG8_SCHED;
            PG8_STAGE(PG8_SB(0, 1), b2 + hstep, voffB);
            PG8_WAIT_V(6); PG8_BAR; PG8_MMA(1, 1, At, B1); PG8_BAR;
            PG8_LDB(B0, 1, 0); PG8_SCHED; PG8_LDA(At, 1, 0); PG8_STAGE(PG8_SA(0, 1), a2 + hstep, voffA);
            PG8_WAIT_L(8); PG8_BAR; PG8_WAIT_L(0); PG8_MMA(0, 0, At, B0); PG8_BAR; PG8_SCHED;
            PG8_LDB(B1, 1, 1); PG8_STAGE(PG8_SB(1, 0), b3, voffB);
            PG8_BAR; PG8_WAIT_L(0); PG8_MMA(0, 1, At, B1); PG8_BAR;
            PG8_LDA(At, 1, 1); PG8_STAGE(PG8_SA(1, 0), a3, voffA);
            PG8_BAR; PG8_WAIT_L(0); PG8_MMA(1, 0, At, B0); PG8_BAR; PG8_SCHED;
            PG8_STAGE(PG8_SB(1, 1), b3 + hstep, voffB);
            PG8_WAIT_V(6); PG8_BAR; PG8_MMA(1, 1, At, B1); PG8_BAR;
            }
        }
        if constexpr (ALIGN_EPI) { if (wr == 0) PG8_BAR; }
        if constexpr (!Epi::AFTER_DRAIN) { E(acc, cur, wr, wc, fr, fq); S.done(cur); }
        if (!has_next) break;
#pragma unroll
        for (int a = 0; a < 2; ++a)
#pragma unroll
            for (int b = 0; b < 2; ++b)
#pragma unroll
                for (int m = 0; m < 4; ++m)
#pragma unroll
                    for (int n = 0; n < 2; ++n) acc[a][b][m][n] = (f32x4){0.f, 0.f, 0.f, 0.f};
        cur = nxt; cA = nA; cB = nB; ++ui;
        if constexpr (ALIGN_EPI) { if (wr == 1) PG8_BAR; }
    }
    PG8_WAIT_V(0);
    if constexpr (!ALIGN_EPI) { if (wr == 0) PG8_BAR; }
    PG8_BAR;
    if constexpr (Epi::AFTER_DRAIN) { E.fused(acc, cur, wr, wc, fr, fq, lds, wid, lane); S.done(cur); }
#undef PG8_SA
#undef PG8_SB
#undef PG8_STAGE
#undef PG8_LDA
#undef PG8_LDB
#undef PG8_MMA
#undef PG8_WAIT_V
#undef PG8_WAIT_L
#undef PG8_BAR
#undef PG8_SCHED
}
}
#define GAS __attribute__((address_space(1)))
#define LAS __attribute__((address_space(3)))
typedef unsigned short bf16;
typedef unsigned v4u __attribute__((ext_vector_type(4)));
typedef float f32x4 __attribute__((ext_vector_type(4)));
typedef short bf16x8 __attribute__((ext_vector_type(8)));
typedef GAS unsigned gu32;
typedef GAS unsigned long long gu64;
#define RLX_AGENT __ATOMIC_RELAXED, __HIP_MEMORY_SCOPE_AGENT
#define LDS_WAIT() asm volatile("s_waitcnt lgkmcnt(0)" ::: "memory")
#define VM_WAIT() asm volatile("s_waitcnt vmcnt(0)" ::: "memory")
__device__ __forceinline__ unsigned long long rt() { return __builtin_amdgcn_s_memrealtime(); }
__device__ __forceinline__ unsigned f2bf(float f) { unsigned u = __builtin_bit_cast(unsigned, f); return (u + 0x7fffu + ((u >> 16) & 1u)) >> 16; }
__device__ __forceinline__ unsigned pk2(float lo, float hi) { return f2bf(lo) | (f2bf(hi) << 16); }

#define XB_TMO      128
#define XB_XCNT(j)  (256  + 64 * (j))
#define XB_XSUB(j)  (1280 + 64 * (j))
#define XB_XGEN(j)  (2304 + 64 * (j))
#define XB_TOP      3328
#define XB_TOPGEN   3392
#define XCD_BAR_WORDS 3456
#define XB_SPIN_CAP (1u << 18)

__device__ __forceinline__ unsigned xb_ld(unsigned* p)              { return __hip_atomic_load(p, __ATOMIC_RELAXED, __HIP_MEMORY_SCOPE_AGENT); }
__device__ __forceinline__ unsigned xb_add(unsigned* p, unsigned v) { return __hip_atomic_fetch_add(p, v, __ATOMIC_RELAXED, __HIP_MEMORY_SCOPE_AGENT); }
__device__ __forceinline__ unsigned xb_xcc_id() { return (unsigned)__builtin_amdgcn_s_getreg((3 << 11) | 20) & 0xFu; }
#define XB_SPIN(cond, bar) do { unsigned _sp = 0; while (cond) { __builtin_amdgcn_s_sleep(1); \
    if ((++_sp & 255u) == 0u) { if (xb_ld(&(bar)[XB_TMO])) break; if (_sp > XB_SPIN_CAP) { atomicAdd(&(bar)[XB_TMO], 1u); break; } } } } while (0)

struct XcdBarrier {
    unsigned* bar; unsigned x;
    volatile LAS unsigned* st;
};

__device__ __forceinline__ XcdBarrier xcd_barrier_post(unsigned* bar, volatile LAS unsigned* st) {
    XcdBarrier b; b.bar = bar; b.x = xb_xcc_id(); b.st = st;
    if (threadIdx.x == 0) (void)xb_add(&bar[XB_XCNT(b.x)], 1u);
    return b;
}
__device__ __forceinline__ void xcd_barrier_complete(unsigned* bar, unsigned x, unsigned& nloc, unsigned& nx) {
    const unsigned G = gridDim.x * gridDim.y * gridDim.z;
    unsigned sum, cnt, mine, sp = 0u;
    for (;;) {
        sum = 0u; cnt = 0u; mine = 0u;
#pragma unroll
        for (unsigned j = 0; j < 16; ++j) { const unsigned c = xb_ld(&bar[XB_XCNT(j)]); sum += c; cnt += (c > 0u) ? 1u : 0u; mine = (j == x) ? c : mine; }
        if (sum == G) break;
        __builtin_amdgcn_s_sleep(1);
        if ((++sp & 255u) == 0u) { if (xb_ld(&bar[XB_TMO])) break; if (sp > XB_SPIN_CAP) { atomicAdd(&bar[XB_TMO], 1u); break; } }
    }
    nloc = mine > 0u ? mine : 1u; nx = cnt > 0u ? cnt : 1u;
}

__device__ __forceinline__ void xcd_barrier(const XcdBarrier& b, const bool leader_thread) {
    asm volatile("s_waitcnt vmcnt(0)" ::: "memory");
    __syncthreads();
    if (leader_thread) {
        unsigned* bar = b.bar;
        __builtin_amdgcn_s_waitcnt(0);
        unsigned nloc = b.st[0], nx = b.st[1];
        if (nloc == 0u) { xcd_barrier_complete(bar, b.x, nloc, nx); b.st[0] = nloc; b.st[1] = nx; }
        const unsigned old = xb_add(&bar[XB_XSUB(b.x)], 1u);
        const unsigned gen = old / nloc;
        if (old + 1u == (gen + 1u) * nloc) {
            __builtin_amdgcn_fence(__ATOMIC_RELEASE, "agent");
            asm volatile("s_waitcnt vmcnt(0)" ::: "memory");
            const unsigned og = xb_add(&bar[XB_TOP], 1u);
            const unsigned tg = og / nx;
            if (og + 1u == (tg + 1u) * nx) xb_add(&bar[XB_TOPGEN], 1u);
            else XB_SPIN(xb_ld(&bar[XB_TOPGEN]) == tg, bar);
            __builtin_amdgcn_fence(__ATOMIC_ACQUIRE, "agent");
            xb_add(&bar[XB_XGEN(b.x)], 1u);
            asm volatile("s_waitcnt vmcnt(0)" ::: "memory");
        } else {
            XB_SPIN(xb_ld(&bar[XB_XGEN(b.x)]) == gen, bar);
            __builtin_amdgcn_fence(__ATOMIC_ACQUIRE, "agent");
            asm volatile("s_waitcnt vmcnt(0)" ::: "memory");
        }
    }
    __syncthreads();
}

typedef short s16x4 __attribute__((ext_vector_type(4)));
typedef float f32x16 __attribute__((ext_vector_type(16)));
typedef float f32x2_t __attribute__((ext_vector_type(2)));
typedef __bf16 bf16x2_t __attribute__((ext_vector_type(2)));
typedef unsigned u32x2 __attribute__((ext_vector_type(2)));
#define CAS __attribute__((address_space(4)))
#define DI __device__ __forceinline__
DI unsigned cvtpk(float lo, float hi) { f32x2_t v = {lo, hi}; bf16x2_t b = __builtin_convertvector(v, bf16x2_t); return __builtin_bit_cast(unsigned, b); }
DI float bf2f(unsigned short b) { return __uint_as_float((unsigned)b << 16); }
DI float wave_sum(float v) {
#pragma unroll
    for (int o = 1; o < 64; o <<= 1) v += __shfl_xor(v, o);
    return v;
}
struct Args { const float* in[19]; float* out; unsigned char* ws; int ph_lo, ph_hi, li, pad; };
enum { I_XP = 0, I_XS, I_CK, I_CV, I_SC, I_SG, I_LN0G, I_LN0B, I_WIN, I_RB, I_CW, I_ALOG, I_DTB, I_GNW, I_WA, I_WB, I_WO, I_LNG, I_LNB };
struct Frame {
    LAS unsigned char* lds; volatile LAS unsigned* MISC; gu32* ctl;
    int tid, lane, wave, vcu, G, bx;
};

DI int win_dst_row(int n) { return n < 4096 ? n : (n < 4112 ? 6144 + (n - 4096) : 4096 + (n - 4112)); }
template <bool WINMAP> DI void tr_item(const float* W, int N, bf16* WT, int ldk, int koff, int kb, int nb, LAS float* scr, int lane) {
    const int k0 = 64 * kb, n0 = 32 * nb;
#pragma unroll 8
    for (int i = 0; i < 32; ++i) { const int kk = 2 * i + (lane >> 5), n = n0 + (lane & 31); scr[kk * 33 + (lane & 31)] = (n < N) ? W[(size_t)(k0 + kk) * N + n] : 0.f; }
    LDS_WAIT(); asm volatile("" ::: "memory");
    const int c = lane & 7;
#pragma unroll
    for (int j = 0; j < 4; ++j) { const int nn = (lane >> 3) + 8 * j, n = n0 + nn; const LAS float* s = scr + (8 * c) * 33 + nn;
        v4u o; o.x = pk2(s[0 * 33], s[1 * 33]); o.y = pk2(s[2 * 33], s[3 * 33]); o.z = pk2(s[4 * 33], s[5 * 33]); o.w = pk2(s[6 * 33], s[7 * 33]);
        if (n < N) { const int dr = WINMAP ? win_dst_row(n) : n; *(GAS v4u*)(WT + (size_t)dr * ldk + koff + k0 + 8 * c) = o; } }
    LDS_WAIT(); asm volatile("" ::: "memory");
}
DI void ln_row(const float* src, const float* g, const float* b, float* hout, bf16* hbout, int lane) {
    const GAS f32x4* xr = (const GAS f32x4*)src + lane;
    f32x4 v[4]; float s = 0.f;
#pragma unroll
    for (int j = 0; j < 4; ++j) { v[j] = xr[64 * j]; s += (v[j].x + v[j].y) + (v[j].z + v[j].w); }
    const float mean = wave_sum(s) * (1.f / D); float s2 = 0.f;
#pragma unroll
    for (int j = 0; j < 4; ++j) { v[j] = v[j] - mean; s2 += (v[j].x * v[j].x + v[j].y * v[j].y) + (v[j].z * v[j].z + v[j].w * v[j].w); }
    const float rstd = 1.f / sqrtf(wave_sum(s2) * (1.f / D) + LN_EPS);
    GAS f32x4* ho = (GAS f32x4*)hout + lane; GAS unsigned long long* o8 = (GAS unsigned long long*)hbout + lane;
#pragma unroll
    for (int j = 0; j < 4; ++j) { const f32x4 gg = ((const GAS f32x4*)g)[lane + 64 * j], bb = ((const GAS f32x4*)b)[lane + 64 * j];
        const f32x4 y = v[j] * rstd * gg + bb; ho[64 * j] = y;
        o8[64 * j] = (unsigned long long)pk2(y.x, y.y) | ((unsigned long long)pk2(y.z, y.w) << 32); }
}
DI void p0_prologue(Frame& F, const CAS Args& A) {
    unsigned char* ws = A.ws;
    LAS float* scr = (LAS float*)(F.lds + RING_OFF + F.wave * 16384);
    const int gw = F.vcu * NWAVES + F.wave, NGW = F.G * NWAVES;
    constexpr int NB_IN = (IN_DIM + 31) / 32;
    constexpr int IT_IN = 16 * NB_IN, IT_A = 8 * 32, IT_O = 16 * 32, IT_L = IT_IN + 2 * IT_A + IT_O;
    for (int it = gw; it < DEPTH * IT_L; it += NGW) {
        const int l = it / IT_L; int r = it % IT_L;
        bf16* WinT = (bf16*)(ws + WS_WIN) + (size_t)l * NIN * D; bf16* WabT = (bf16*)(ws + WS_WAB) + (size_t)l * D * 1024; bf16* WoT = (bf16*)(ws + WS_WO) + (size_t)l * D * D;
        if (r < IT_IN) { tr_item<true>(A.in[I_WIN] + (size_t)l * D * IN_DIM, IN_DIM, WinT, D, 0, r / NB_IN, r % NB_IN, scr, F.lane); continue; } r -= IT_IN;
        if (r < IT_A) { tr_item<false>(A.in[I_WA] + (size_t)l * AW * D, D, WabT, 1024, 0, r / 32, r % 32, scr, F.lane); continue; } r -= IT_A;
        if (r < IT_A) { tr_item<false>(A.in[I_WB] + (size_t)l * BW * D, D, WabT, 1024, 512, r / 32, r % 32, scr, F.lane); continue; } r -= IT_A;
        tr_item<false>(A.in[I_WO] + (size_t)l * D * D, D, WoT, D, 0, r / 32, r % 32, scr, F.lane);
    }
    { const int gt = F.vcu * (NWAVES * 64) + F.tid, NGT = F.G * NWAVES * 64; constexpr int PER_L = (NIN - IN_DIM) * D * 2 / 16;
      for (int i = gt; i < DEPTH * PER_L; i += NGT) { const int l = i / PER_L, r = i % PER_L;
          *(GAS v4u*)((unsigned char*)ws + WS_WIN + ((size_t)l * NIN + IN_DIM) * D * 2 + (size_t)r * 16) = (v4u){0u, 0u, 0u, 0u}; } }
    float* H = A.out + O_Y; bf16* HB = (bf16*)(ws + WS_HB);
    for (int m = gw; m < M; m += NGW) {
        const float* src = (m < MP) ? A.in[I_XP] + (size_t)m * D : A.in[I_XS] + (size_t)(m - MP) * D;
        ln_row(src, A.in[I_LN0G], A.in[I_LN0B], H + (size_t)m * D, HB + (size_t)m * D, F.lane);
    }
}

namespace att {
DI int crow(int r, int hi) { return (r & 3) + 8 * (r >> 2) + 4 * hi; }
typedef short v4i16_t __attribute__((ext_vector_type(4)));
DI s16x4 vtr(const LAS unsigned char* p) { return __builtin_bit_cast(s16x4, __builtin_amdgcn_ds_read_tr16_b64_v4i16((LAS v4i16_t*)p)); }
DI bf16x8 ldfrag(const bf16* p) { return *(const GAS bf16x8*)p; }
DI bf16x8 ldfrag(const float* p) { const f32x4 a = *(const GAS f32x4*)p, b = *(const GAS f32x4*)(p + 4); v4u w; w.x = cvtpk(a[0], a[1]); w.y = cvtpk(a[2], a[3]); w.z = cvtpk(b[0], b[1]); w.w = cvtpk(b[2], b[3]); return __builtin_bit_cast(bf16x8, w); }
struct State { f32x16 o0, o1; float m, l; };
DI bf16x8 packp(const f32x16& p, int s) { v4u w; w.x = cvtpk(p[8 * s], p[8 * s + 1]); w.y = cvtpk(p[8 * s + 2], p[8 * s + 3]); w.z = cvtpk(p[8 * s + 4], p[8 * s + 5]); w.w = cvtpk(p[8 * s + 6], p[8 * s + 7]); return __builtin_bit_cast(bf16x8, w); }
template <typename T> DI void tile(State& st, const bf16x8 (&qr)[4], const T* kb, const T* vb, int pitch, int nvalid, int dq, const LAS float* btab, LAS unsigned char* vl, int lane) {
    const int r32 = lane & 31, hq = lane >> 5;
    bf16x8 kf[2][4];
#pragma unroll
    for (int sub = 0; sub < 2; ++sub) { int row = sub * 32 + r32; row = row < nvalid ? row : nvalid - 1;
#pragma unroll
        for (int ks = 0; ks < 4; ++ks) kf[sub][ks] = ldfrag(kb + (size_t)row * pitch + ks * 16 + hq * 8); }
    bf16x8 vreg[8];
#pragma unroll
    for (int i = 0; i < 8; ++i) { int row = i * 8 + (lane >> 3); row = row < nvalid ? row : nvalid - 1; vreg[i] = ldfrag(vb + (size_t)row * pitch + (lane & 7) * 8); }
    asm volatile("" ::: "memory");
#pragma unroll
    for (int i = 0; i < 8; ++i) { const int row = i * 8 + (lane >> 3); *(LAS bf16x8*)(vl + row * 128 + (((lane & 7) * 16) ^ (((row >> 1) & 1) << 6))) = vreg[i]; }
    f32x16 p0, p1;
#pragma unroll
    for (int r = 0; r < 16; ++r) { p0[r] = 0.f; p1[r] = 0.f; }
#pragma unroll
    for (int ks = 0; ks < 4; ++ks) { p0 = __builtin_amdgcn_mfma_f32_32x32x16_bf16(kf[0][ks], qr[ks], p0, 0, 0, 0); p1 = __builtin_amdgcn_mfma_f32_32x32x16_bf16(kf[1][ks], qr[ks], p1, 0, 0, 0); }
    if (dq >= 191) { const float bc = btab[191];
#pragma unroll
        for (int r = 0; r < 16; ++r) { p0[r] += bc; p1[r] += bc; }
    } else {
#pragma unroll
        for (int r = 0; r < 16; ++r) { int i0 = dq + r32 - crow(r, hq) + 63; int i1 = i0 - 32;
            i0 = i0 < 0 ? 0 : (i0 > 191 ? 191 : i0); i1 = i1 < 0 ? 0 : (i1 > 191 ? 191 : i1); p0[r] += btab[i0]; p1[r] += btab[i1]; }
    }
    if (nvalid < 64) {
#pragma unroll
        for (int r = 0; r < 16; ++r) { if (crow(r, hq) >= nvalid) p0[r] = -INFINITY; if (crow(r, hq) + 32 >= nvalid) p1[r] = -INFINITY; }
    }
    float mx = p0[0];
#pragma unroll
    for (int r = 1; r < 16; ++r) mx = fmaxf(mx, p0[r]);
#pragma unroll
    for (int r = 0; r < 16; ++r) mx = fmaxf(mx, p1[r]);
    mx = fmaxf(mx, __shfl_xor(mx, 32));
    const float mnew = fmaxf(st.m, mx), alpha = __builtin_amdgcn_exp2f(st.m - mnew); st.m = mnew;
    float sum = 0.f;
#pragma unroll
    for (int r = 0; r < 16; ++r) { p0[r] = __builtin_amdgcn_exp2f(p0[r] - mnew); p1[r] = __builtin_amdgcn_exp2f(p1[r] - mnew); sum += p0[r] + p1[r]; }
    st.l = st.l * alpha + sum;
#pragma unroll
    for (int r = 0; r < 16; ++r) { st.o0[r] *= alpha; st.o1[r] *= alpha; }
    bf16x8 pb[4]; pb[0] = packp(p0, 0); pb[1] = packp(p0, 1); pb[2] = packp(p1, 0); pb[3] = packp(p1, 1);
    asm volatile("" ::: "memory");
    const int blk = (lane >> 4) & 1, qq = (lane & 15) >> 2, pp = lane & 3, swz = ((qq >> 1) & 1) << 6;
#pragma unroll
    for (int s4 = 0; s4 < 4; ++s4) {
        const int rb = 16 * s4 + 4 * hq + qq;
#pragma unroll
        for (int d0 = 0; d0 < 2; ++d0) {
            const int cb = (d0 * 64 + blk * 32 + pp * 8) ^ swz;
            const s16x4 lo = vtr(vl + rb * 128 + cb), hi = vtr(vl + (rb + 8) * 128 + cb);
            const bf16x8 a = __builtin_shufflevector(lo, hi, 0, 1, 2, 3, 4, 5, 6, 7);
            if (d0 == 0) st.o0 = __builtin_amdgcn_mfma_f32_32x32x16_bf16(a, pb[s4], st.o0, 0, 0, 0);
            else st.o1 = __builtin_amdgcn_mfma_f32_32x32x16_bf16(a, pb[s4], st.o1, 0, 0, 0);
        }
    }
    asm volatile("" ::: "memory");
}
DI void finish(State& st, bf16* Orow0, const bf16* Zrow0, int lane) {
    const int r32 = lane & 31, hq = lane >> 5;
    const float lt = st.l + __shfl_xor(st.l, 32), inv = 1.0f / lt;
#pragma unroll
    for (int d0 = 0; d0 < 2; ++d0)
#pragma unroll
        for (int g = 0; g < 4; ++g) { const int d = 32 * d0 + 8 * g + 4 * hq;
            const u32x2 z = *(const GAS u32x2*)(Zrow0 + (size_t)r32 * 512 + d);
            const f32x16& o = d0 ? st.o1 : st.o0;
            const float a0 = o[4 * g] * inv * __uint_as_float(z.x << 16), a1 = o[4 * g + 1] * inv * __uint_as_float(z.x & 0xffff0000u);
            const float a2 = o[4 * g + 2] * inv * __uint_as_float(z.y << 16), a3 = o[4 * g + 3] * inv * __uint_as_float(z.y & 0xffff0000u);
            u32x2 w; w.x = cvtpk(a0, a1); w.y = cvtpk(a2, a3);
            *(GAS u32x2*)(Orow0 + (size_t)r32 * 1024 + d) = w; }
}
}

DI void p_attention(Frame& F, const CAS Args& A, int l) {
    unsigned char* ws = A.ws;
    bf16* OAB = (bf16*)(ws + WS_OAB); const bf16* KA = (const bf16*)(ws + WS_KA); const bf16* VA = (const bf16*)(ws + WS_VA); const bf16* SZA = (const bf16*)(ws + WS_SZA);
    LAS float* btab_all = (LAS float*)(F.lds + BIAS_OFF);
    for (int i = F.tid; i < AH * NREL; i += NWAVES * 64) btab_all[i] = A.in[I_RB][(size_t)l * AH * NREL + i] * LOG2E;
    __syncthreads();
    LAS unsigned char* vl = F.lds + RING_OFF + F.wave * 16384;
    const int lane = F.lane, r32 = lane & 31, hq = lane >> 5;
    constexpr int NU_P = BATCH * (SEQ / CHUNK) * 2, NU = NU_P + DECB;
    for (int u = F.vcu; u < NU; u += F.G) {
        att::State st;
#pragma unroll
        for (int r = 0; r < 16; ++r) { st.o0[r] = 0.f; st.o1[r] = 0.f; }
        st.m = -1e30f; st.l = 0.f;
        bf16x8 qr[4];
        if (u < NU_P) {
            const int b = u >> 8, c = (u & 255) >> 1, h = (u & 1) * 4 + (F.wave >> 1), hf = F.wave & 1;
            const size_t qrow0 = (size_t)b * SEQ + c * CHUNK + hf * 32;
            bf16* Qp = OAB + qrow0 * 1024 + h * 64;
#pragma unroll
            for (int ks = 0; ks < 4; ++ks) qr[ks] = att::ldfrag(Qp + (size_t)r32 * 1024 + ks * 16 + hq * 8);
            const LAS float* btab = btab_all + h * NREL;
            for (int j = (c >= 8 ? c - 8 : 0); j <= c; ++j) {
                const size_t kr0 = ((size_t)b * SEQ + j * CHUNK) * 512 + h * 64;
                att::tile<bf16>(st, qr, KA + kr0, VA + kr0, 512, 64, (c - j) * 64 + hf * 32, btab, vl, lane);
            }
            att::finish(st, Qp, SZA + qrow0 * 512 + h * 64, lane);
        } else {
            const int b = u - NU_P, h = F.wave;
            const size_t qrow0 = (size_t)MP + b * DECS;
            bf16* Qp = OAB + qrow0 * 1024 + h * 64;
#pragma unroll
            for (int ks = 0; ks < 4; ++ks) qr[ks] = att::ldfrag(Qp + (size_t)r32 * 1024 + ks * 16 + hq * 8);
            const LAS float* btab = btab_all + h * NREL;
            const float* ck = A.in[I_CK] + ((size_t)(l * DECB + b) * ATTW) * 512 + h * 64;
            const float* cv = A.in[I_CV] + ((size_t)(l * DECB + b) * ATTW) * 512 + h * 64;
            for (int j = 0; j < 8; ++j) att::tile<float>(st, qr, ck + (size_t)j * 64 * 512, cv + (size_t)j * 64 * 512, 512, 64, 512 - 64 * j, btab, vl, lane);
            att::tile<bf16>(st, qr, KA + qrow0 * 512 + h * 64, VA + qrow0 * 512 + h * 64, 512, 32, 0, btab, vl, lane);
            att::finish(st, Qp, SZA + qrow0 * 512 + h * 64, lane);
        }
    }
}

DI void p_gdn_slow(Frame& F, const CAS Args& A, int l) {
    unsigned char* ws = A.ws;
    bf16* OAB = (bf16*)(ws + WS_OAB); const bf16* XB = (const bf16*)(ws + WS_XB); const float* G = (const float*)(ws + WS_G); const float* BETA = (const float*)(ws + WS_BETA);
    int sid = -1;
    if (F.vcu < 32) { if (F.wave == 0) sid = F.vcu; } else if (F.vcu < 64) sid = 32 + (F.vcu - 32) * 8 + F.wave;
    if (sid < 0) return;
    const bool prompt = sid < 32; const int sq = prompt ? sid : sid - 32; const int b = sq >> 3, h = sq & 7, T = prompt ? SEQ : DECS;
    const size_t rowbase = prompt ? (size_t)b * SEQ : (size_t)MP + b * DECS;
    const int e = F.lane, cq = h * 64 + e, ck = 512 + cq, cv = 1024 + cq;
    const float* cw = A.in[I_CW] + (size_t)l * 4 * BQKV;
    LAS float* wl = (LAS float*)(F.lds + RING_OFF + F.wave * 16384) + 128;
#pragma unroll
    for (int i = 0; i < 4; ++i) { wl[i * 64 + e] = cw[i * BQKV + cq]; wl[(4 + i) * 64 + e] = cw[i * BQKV + ck]; wl[(8 + i) * 64 + e] = cw[i * BQKV + cv]; }
    float xq[3] = {0.f, 0.f, 0.f}, xk[3] = {0.f, 0.f, 0.f}, xv[3] = {0.f, 0.f, 0.f};
    float S[64];
#pragma unroll
    for (int d = 0; d < 64; ++d) S[d] = 0.f;
    if (!prompt) {
        const float* sc = A.in[I_SC] + ((size_t)(l * DECB + b) * 3) * BQKV;
#pragma unroll
        for (int i = 0; i < 3; ++i) { xq[i] = sc[i * BQKV + cq]; xk[i] = sc[i * BQKV + ck]; xv[i] = sc[i * BQKV + cv]; }
        const float* s0 = A.in[I_SG] + ((size_t)(l * DECB + b) * BH + h) * 4096;
#pragma unroll
        for (int d = 0; d < 64; ++d) S[d] = s0[d * 64 + e];
    }
    const float nw = A.in[I_GNW][l * 64 + e];
    const float nAexp = -expf(A.in[I_ALOG][l * 8 + h]), dtb = A.in[I_DTB][l * 8 + h];
    LAS float* kbuf = (LAS float*)(F.lds + RING_OFF + F.wave * 16384); LAS float* qbuf = kbuf + 64;
    for (int t = 0; t < T; ++t) {
        const size_t row = rowbase + t;
        const float nq = bf2f(XB[row * BQKV + cq]), nk = bf2f(XB[row * BQKV + ck]), nv = bf2f(XB[row * BQKV + cv]);
        const float aq = xq[0] * wl[e] + xq[1] * wl[64 + e] + xq[2] * wl[128 + e] + nq * wl[192 + e];
        const float ak = xk[0] * wl[256 + e] + xk[1] * wl[320 + e] + xk[2] * wl[384 + e] + nk * wl[448 + e];
        const float av = xv[0] * wl[512 + e] + xv[1] * wl[576 + e] + xv[2] * wl[640 + e] + nv * wl[704 + e];
        xq[0] = xq[1]; xq[1] = xq[2]; xq[2] = nq; xk[0] = xk[1]; xk[1] = xk[2]; xk[2] = nk; xv[0] = xv[1]; xv[1] = xv[2]; xv[2] = nv;
        const float q = aq / (1.f + expf(-aq)), k = ak / (1.f + expf(-ak)), v = av / (1.f + expf(-av));
        const float sqq = wave_sum(q * q), skk = wave_sum(k * k);
        const float qn = q * (1.0f / sqrtf(sqq + NORM_EPS)) * 0.125f, kn = k * (1.0f / sqrtf(skk + NORM_EPS));
        const float xa = G[row * 8 + h] + dtb, sp = xa > 20.f ? xa : log1pf(expf(xa));
        const float g = nAexp * sp, beta = 1.0f / (1.0f + expf(-BETA[row * 8 + h])), a = expf(g);
        asm volatile("" ::: "memory");
        kbuf[e] = kn; qbuf[e] = qn;
        asm volatile("s_waitcnt lgkmcnt(0)" ::: "memory");
        float kS = 0.f;
#pragma unroll
        for (int d = 0; d < 64; ++d) kS += kbuf[d] * S[d];
        const float coef = beta * (v - a * kS);
        float o = 0.f;
#pragma unroll
        for (int d = 0; d < 64; ++d) { S[d] = a * S[d] + kbuf[d] * coef; o += qbuf[d] * S[d]; }
        asm volatile("s_waitcnt lgkmcnt(0)" ::: "memory");
        const float ms = wave_sum(o * o) * (1.f / 64.f);
        const float on = o * (1.0f / sqrtf(ms + NORM_EPS)) * nw;
        bf16* op = OAB + row * 1024 + 512 + cq;
        *op = (bf16)f2bf(on * bf2f(*op));
    }
    float* so = A.out + (prompt ? O_GP + ((size_t)(l * BATCH + b) * BH + h) * 4096 : O_GS + ((size_t)(l * DECB + b) * BH + h) * 4096);
#pragma unroll
    for (int d = 0; d < 64; ++d) so[d * 64 + e] = S[d];
}


namespace gdn {
DI int crow(int r, int h) { return (r & 3) + 8 * (r >> 2) + 4 * h; }
DI int pfun4(int dk) { return (dk & 32) | (((dk >> 2) & 3) << 3) | (((dk >> 4) & 1) << 2); }
typedef short v4i16_t __attribute__((ext_vector_type(4)));
DI s16x4 vtr(const LAS unsigned char* p) { return __builtin_bit_cast(s16x4, __builtin_amdgcn_ds_read_tr16_b64_v4i16((LAS v4i16_t*)p)); }
DI bf16x8 packacc(const f32x16& p, int s) { v4u w; w.x = cvtpk(p[8 * s], p[8 * s + 1]); w.y = cvtpk(p[8 * s + 2], p[8 * s + 3]); w.z = cvtpk(p[8 * s + 4], p[8 * s + 5]); w.w = cvtpk(p[8 * s + 6], p[8 * s + 7]); return __builtin_bit_cast(bf16x8, w); }
DI f32x16 zero16() { f32x16 z;
#pragma unroll
    for (int i = 0; i < 16; ++i) z[i] = 0.f;
    return z; }
#define MFMA32(a, b, c) __builtin_amdgcn_mfma_f32_32x32x16_bf16((a), (b), (c), 0, 0, 0)
DI bf16x8 trfrag(const LAS unsigned char* img, int rlo, int rhi, int ct, int lane) {
    const int blk = (lane >> 4) & 1, qq = (lane & 15) >> 2, pp = lane & 3, swz = ((qq >> 1) & 1) << 6;
    const int cb = (ct * 64 + blk * 32 + pp * 8) ^ swz;
    const s16x4 lo = vtr(img + (rlo + qq) * 128 + cb), hi = vtr(img + (rhi + qq) * 128 + cb);
    return __builtin_shufflevector(lo, hi, 0, 1, 2, 3, 4, 5, 6, 7);
}
template <int CMAX> DI void subst(float (&T)[64], const LAS float* MT, int myrow) {
#pragma unroll
    for (int c = CMAX; c >= 0; --c) {
        float acc = (myrow == c) ? 1.f : 0.f;
#pragma unroll
        for (int j4 = ((c + 1) & ~3); j4 <= CMAX; j4 += 4) {
            const f32x4 m = *(const LAS f32x4*)(MT + c * 68 + j4);
#pragma unroll
            for (int t = 0; t < 4; ++t) if (j4 + t > c) acc -= T[j4 + t] * m[t];
            if ((j4 & 12) == 12) asm volatile("" : "+v"(acc) :: "memory");
        }
        asm volatile("" : "+v"(acc) :: "memory");
        T[c] = acc;
    }
}
}

DI void p_conv(Frame& F, const CAS Args& A, int l) {
    unsigned char* ws = A.ws;
    bf16* XB = (bf16*)(ws + WS_XB); const bf16* HALO = (const bf16*)(ws + WS_HALO);
    const float* cw = A.in[I_CW] + (size_t)l * 4 * BQKV;
    const int gw = F.vcu * NWAVES + F.wave, NGW = F.G * NWAVES, lane = F.lane;
    constexpr int NU = (MP / 64) * 3 + DECB * 3;
    for (int u = gw; u < NU; u += NGW) {
        const bool prompt = u < (MP / 64) * 3;
        const int ci = prompt ? u / 3 : (u - (MP / 64) * 3) / 3, sec = prompt ? u % 3 : (u - (MP / 64) * 3) % 3;
        const size_t row0 = prompt ? (size_t)ci * 64 : (size_t)MP + ci * DECS; const int nrows = prompt ? 64 : DECS;
        const int col = sec * 512 + lane * 8;
        float w0[8], w1[8], w2[8], w3[8], x0[8], x1[8], x2[8];
#pragma unroll
        for (int j = 0; j < 8; ++j) { w0[j] = cw[col + j]; w1[j] = cw[BQKV + col + j]; w2[j] = cw[2 * BQKV + col + j]; w3[j] = cw[3 * BQKV + col + j]; x0[j] = 0.f; x1[j] = 0.f; x2[j] = 0.f; }
        if (prompt) {
            if ((ci & 127) != 0) {
                const bf16* hp = HALO + (size_t)(ci - 1) * 3 * BQKV + col;
                const v4u a = *(const GAS v4u*)hp, b = *(const GAS v4u*)(hp + BQKV), c = *(const GAS v4u*)(hp + 2 * BQKV);
#pragma unroll
                for (int j = 0; j < 4; ++j) { x0[2 * j] = __uint_as_float(a[j] << 16); x0[2 * j + 1] = __uint_as_float(a[j] & 0xffff0000u);
                    x1[2 * j] = __uint_as_float(b[j] << 16); x1[2 * j + 1] = __uint_as_float(b[j] & 0xffff0000u);
                    x2[2 * j] = __uint_as_float(c[j] << 16); x2[2 * j + 1] = __uint_as_float(c[j] & 0xffff0000u); }
            }
        } else {
            const float* sc = A.in[I_SC] + ((size_t)(l * DECB + ci) * 3) * BQKV + col;
#pragma unroll
            for (int j = 0; j < 8; ++j) { x0[j] = sc[j]; x1[j] = sc[BQKV + j]; x2[j] = sc[2 * BQKV + j]; }
        }
        bf16* rp = XB + row0 * BQKV + col;
        for (int t = 0; t < nrows; ++t, rp += BQKV) {
            const v4u raw = *(const GAS v4u*)rp; float xn[8], y[8]; float ss = 0.f;
#pragma unroll
            for (int j = 0; j < 4; ++j) { xn[2 * j] = __uint_as_float(raw[j] << 16); xn[2 * j + 1] = __uint_as_float(raw[j] & 0xffff0000u); }
#pragma unroll
            for (int j = 0; j < 8; ++j) { const float a = x0[j] * w0[j] + x1[j] * w1[j] + x2[j] * w2[j] + xn[j] * w3[j]; y[j] = a * __builtin_amdgcn_rcpf(1.0f + __expf(-a)); ss += y[j] * y[j];
                x0[j] = x1[j]; x1[j] = x2[j]; x2[j] = xn[j]; }
            if (sec < 2) {
                ss += __shfl_xor(ss, 1); ss += __shfl_xor(ss, 2); ss += __shfl_xor(ss, 4);
                const float sc = (1.0f / sqrtf(ss + NORM_EPS)) * (sec == 0 ? 0.125f : 1.0f);
#pragma unroll
                for (int j = 0; j < 8; ++j) y[j] *= sc;
            }
            v4u o; o.x = cvtpk(y[0], y[1]); o.y = cvtpk(y[2], y[3]); o.z = cvtpk(y[4], y[5]); o.w = cvtpk(y[6], y[7]);
            *(GAS v4u*)rp = o;
        }
    }
}

DI void gdn_prep_unit(const CAS Args& A, int l, LAS unsigned char* pw, int lane, int uid, size_t row0, int nvalid, int h) {
    using namespace gdn;
    unsigned char* ws = A.ws;
    const bf16* QKV = (const bf16*)(ws + WS_XB);
    const int r32 = lane & 31, hq = lane >> 5;
    LAS float* MT = (LAS float*)pw;
    LAS unsigned char* Kimg = pw; LAS unsigned char* Vimg = pw + 8192;
    LAS float* tb_gc = (LAS float*)(pw + 17408); LAS float* tb_beta = tb_gc + 64; LAS float* tb_bg = tb_gc + 128; LAS float* tb_dl = tb_gc + 192;
    const int qc = h * 64, kc = 512 + h * 64, vc = 1024 + h * 64;
    {
        const bool valid = lane < nvalid; const size_t row = row0 + (valid ? lane : 0);
        const float araw = ((const float*)(ws + WS_G))[row * 8 + h], braw = ((const float*)(ws + WS_BETA))[row * 8 + h];
        const float xa = araw + A.in[I_DTB][l * 8 + h], sp = xa > 20.f ? xa : log1pf(expf(xa));
        float g = valid ? -expf(A.in[I_ALOG][l * 8 + h]) * sp : 0.f; const float beta = valid ? 1.0f / (1.0f + expf(-braw)) : 0.f;
#pragma unroll
        for (int off = 1; off < 64; off <<= 1) { const float t2 = __shfl_up(g, off); if (lane >= off) g += t2; }
        const float glast = __shfl(g, 63);
        tb_gc[lane] = g; tb_beta[lane] = beta; tb_bg[lane] = beta * expf(g); tb_dl[lane] = expf(glast - g);
        if (lane == 0) ((float*)(ws + WS_GE))[uid] = expf(glast);
    }
    asm volatile("s_waitcnt lgkmcnt(0)" ::: "memory");
    bf16x8 kR[2][4], qR[2][4];
#pragma unroll
    for (int rt = 0; rt < 2; ++rt) { const int row = 32 * rt + r32; const bool ok = row < nvalid; const bf16* bp = QKV + (row0 + (ok ? row : 0)) * BQKV + 8 * hq;
#pragma unroll
        for (int ks = 0; ks < 4; ++ks) { bf16x8 kk = *(const GAS bf16x8*)(bp + kc + 16 * ks), qq = *(const GAS bf16x8*)(bp + qc + 16 * ks);
            if (!ok) { kk = (bf16x8){0, 0, 0, 0, 0, 0, 0, 0}; qq = kk; } kR[rt][ks] = kk; qR[rt][ks] = qq; } }
#pragma unroll
    for (int tix = 0; tix < 3; ++tix) { const int a = tix == 0 ? 0 : 1, b = tix == 2 ? 1 : 0;
        f32x16 Gt = zero16();
#pragma unroll
        for (int ks = 0; ks < 4; ++ks) Gt = MFMA32(kR[a][ks], kR[b][ks], Gt);
        const int c = 32 * b + r32; const float gcc = tb_gc[c];
#pragma unroll
        for (int g4 = 0; g4 < 4; ++g4) { const int j0 = 32 * a + 8 * g4 + 4 * hq;
            const f32x4 gj = *(const LAS f32x4*)(tb_gc + j0), bj = *(const LAS f32x4*)(tb_beta + j0); f32x4 mv;
#pragma unroll
            for (int t = 0; t < 4; ++t) mv[t] = (j0 + t > c) ? bj[t] * __expf(gj[t] - gcc) * Gt[4 * g4 + t] : 0.f;
            *(LAS f32x4*)(MT + c * 68 + j0) = mv; } }
    bf16x8 Xp[3][2];
#pragma unroll
    for (int tix = 0; tix < 3; ++tix) { const int jt = tix == 2 ? 1 : 0, it = tix == 0 ? 0 : 1;
        f32x16 Xt = zero16();
#pragma unroll
        for (int ks = 0; ks < 4; ++ks) Xt = MFMA32(kR[jt][ks], qR[it][ks], Xt);
        const int i_ = 32 * it + r32; const float gci = tb_gc[i_];
#pragma unroll
        for (int g4 = 0; g4 < 4; ++g4) { const int j0 = 32 * jt + 8 * g4 + 4 * hq; const f32x4 gj = *(const LAS f32x4*)(tb_gc + j0);
#pragma unroll
            for (int t = 0; t < 4; ++t) Xt[4 * g4 + t] = (i_ >= j0 + t) ? Xt[4 * g4 + t] * __expf(gci - gj[t]) : 0.f; }
        Xp[tix][0] = packacc(Xt, 0); Xp[tix][1] = packacc(Xt, 1); }
    asm volatile("s_waitcnt lgkmcnt(0)" ::: "memory");
#if defined(PREP_CUT) && PREP_CUT == 1
    *(GAS bf16x8*)(ws + WS_GAO + (size_t)uid * 8192 + lane * 16) = Xp[0][0] + Xp[1][0] + Xp[2][0] + Xp[0][1] + Xp[1][1] + Xp[2][1]; return;
#endif
    bf16x8 Tv0[2], Tw0[2], Tv1[4], Tw1[4];
    {
        float T[64];
#pragma unroll
        for (int c = 0; c < 64; ++c) T[c] = 0.f;
        subst<31>(T, MT, r32);
#pragma unroll
        for (int ks = 0; ks < 2; ++ks) { const f32x4 b0 = *(const LAS f32x4*)(tb_beta + 16 * ks + 8 * hq), b1 = *(const LAS f32x4*)(tb_beta + 16 * ks + 8 * hq + 4);
            const f32x4 g0 = *(const LAS f32x4*)(tb_bg + 16 * ks + 8 * hq), g1 = *(const LAS f32x4*)(tb_bg + 16 * ks + 8 * hq + 4);
            float tv[8], tw[8];
#pragma unroll
            for (int j = 0; j < 8; ++j) { const float tt = hq ? T[16 * ks + 8 + j] : T[16 * ks + j]; tv[j] = tt * (j < 4 ? b0[j & 3] : b1[j & 3]); tw[j] = tt * (j < 4 ? g0[j & 3] : g1[j & 3]); }
            v4u a, b; a.x = cvtpk(tv[0], tv[1]); a.y = cvtpk(tv[2], tv[3]); a.z = cvtpk(tv[4], tv[5]); a.w = cvtpk(tv[6], tv[7]);
            b.x = cvtpk(tw[0], tw[1]); b.y = cvtpk(tw[2], tw[3]); b.z = cvtpk(tw[4], tw[5]); b.w = cvtpk(tw[6], tw[7]);
            Tv0[ks] = __builtin_bit_cast(bf16x8, a); Tw0[ks] = __builtin_bit_cast(bf16x8, b); }
    }
    {
        float T[64];
        subst<63>(T, MT, 32 + r32);
#pragma unroll
        for (int ks = 0; ks < 4; ++ks) { const f32x4 b0 = *(const LAS f32x4*)(tb_beta + 16 * ks + 8 * hq), b1 = *(const LAS f32x4*)(tb_beta + 16 * ks + 8 * hq + 4);
            const f32x4 g0 = *(const LAS f32x4*)(tb_bg + 16 * ks + 8 * hq), g1 = *(const LAS f32x4*)(tb_bg + 16 * ks + 8 * hq + 4);
            float tv[8], tw[8];
#pragma unroll
            for (int j = 0; j < 8; ++j) { const float tt = hq ? T[16 * ks + 8 + j] : T[16 * ks + j]; tv[j] = tt * (j < 4 ? b0[j & 3] : b1[j & 3]); tw[j] = tt * (j < 4 ? g0[j & 3] : g1[j & 3]); }
            v4u a, b; a.x = cvtpk(tv[0], tv[1]); a.y = cvtpk(tv[2], tv[3]); a.z = cvtpk(tv[4], tv[5]); a.w = cvtpk(tv[6], tv[7]);
            b.x = cvtpk(tw[0], tw[1]); b.y = cvtpk(tw[2], tw[3]); b.z = cvtpk(tw[4], tw[5]); b.w = cvtpk(tw[6], tw[7]);
            Tv1[ks] = __builtin_bit_cast(bf16x8, a); Tw1[ks] = __builtin_bit_cast(bf16x8, b); }
    }
    asm volatile("s_waitcnt lgkmcnt(0)" ::: "memory");
#if defined(PREP_CUT) && PREP_CUT == 2
    *(GAS bf16x8*)(ws + WS_GAO + (size_t)uid * 8192 + lane * 16) = Xp[0][0] + Xp[1][0] + Xp[2][0] + Xp[0][1] + Xp[1][1] + Xp[2][1] + Tv0[0] + Tv0[1] + Tw0[0] + Tw0[1] + Tv1[0] + Tv1[1] + Tv1[2] + Tv1[3] + Tw1[0] + Tw1[1] + Tw1[2] + Tw1[3]; return;
#endif
#pragma unroll
    for (int i = 0; i < 8; ++i) { const int row = i * 8 + (lane >> 3); const bool ok = row < nvalid; const bf16* bp = QKV + (row0 + (ok ? row : 0)) * BQKV + (lane & 7) * 8;
        bf16x8 kk = *(const GAS bf16x8*)(bp + kc), vv = *(const GAS bf16x8*)(bp + vc);
        if (!ok) { kk = (bf16x8){0, 0, 0, 0, 0, 0, 0, 0}; vv = kk; }
        const int off = row * 128 + (((lane & 7) * 16) ^ (((row >> 1) & 1) << 6));
        *(LAS bf16x8*)(Kimg + off) = kk; *(LAS bf16x8*)(Vimg + off) = vv; }
    asm volatile("s_waitcnt lgkmcnt(0)" ::: "memory");
    unsigned char* gAo = ws + WS_GAO + (size_t)uid * 8192; unsigned char* gBs = ws + WS_GBS + (size_t)uid * 8192;
    unsigned char* gCo = ws + WS_GCO + (size_t)uid * 8192; unsigned char* gCs = ws + WS_GCS + (size_t)uid * 8192;
    {
        bf16x8 Ub[2][2][2], Ud[2][2][2];
#pragma unroll
        for (int rt = 0; rt < 2; ++rt)
#pragma unroll
            for (int ct = 0; ct < 2; ++ct) { f32x16 acc = zero16();
#pragma unroll
                for (int ks = 0; ks < 4; ++ks) if (rt == 1 || ks < 2) acc = MFMA32(rt ? Tv1[ks] : Tv0[ks], trfrag(Vimg, 16 * ks + 8 * hq, 16 * ks + 8 * hq + 4, ct, lane), acc);
                Ub[rt][ct][0] = packacc(acc, 0); Ub[rt][ct][1] = packacc(acc, 1);
#pragma unroll
                for (int g4 = 0; g4 < 4; ++g4) { const f32x4 dl = *(const LAS f32x4*)(tb_dl + 32 * rt + 8 * g4 + 4 * hq);
#pragma unroll
                    for (int t = 0; t < 4; ++t) acc[4 * g4 + t] *= dl[t]; }
                Ud[rt][ct][0] = packacc(acc, 0); Ud[rt][ct][1] = packacc(acc, 1); }
#pragma unroll
        for (int it = 0; it < 2; ++it)
#pragma unroll
            for (int ct = 0; ct < 2; ++ct) { f32x16 acc = zero16();
#pragma unroll
                for (int jt = 0; jt <= it; ++jt)
#pragma unroll
                    for (int s = 0; s < 2; ++s) acc = MFMA32(Xp[jt + it][s], Ub[jt][ct][s], acc);
#pragma unroll
                for (int g4 = 0; g4 < 4; ++g4) { u32x2 o; o.x = cvtpk(acc[4 * g4], acc[4 * g4 + 1]); o.y = cvtpk(acc[4 * g4 + 2], acc[4 * g4 + 3]);
                    *(GAS u32x2*)(gCo + ((32 * ct + r32) * 64 + 32 * it + 8 * g4 + 4 * hq) * 2) = o; } }
#pragma unroll
        for (int kt = 0; kt < 2; ++kt)
#pragma unroll
            for (int ct = 0; ct < 2; ++ct) { f32x16 acc = zero16();
#pragma unroll
                for (int lt = 0; lt < 2; ++lt)
#pragma unroll
                    for (int s = 0; s < 2; ++s) acc = MFMA32(trfrag(Kimg, 32 * lt + 16 * s + 4 * hq, 32 * lt + 16 * s + 8 + 4 * hq, kt, lane), Ud[lt][ct][s], acc);
#pragma unroll
                for (int g4 = 0; g4 < 4; ++g4) { u32x2 o; o.x = cvtpk(acc[4 * g4], acc[4 * g4 + 1]); o.y = cvtpk(acc[4 * g4 + 2], acc[4 * g4 + 3]);
                    *(GAS u32x2*)(gCs + ((32 * ct + r32) * 64 + 32 * kt + 8 * g4 + 4 * hq) * 2) = o; } }
    }
    {
        bf16x8 Wn[2][2][2], Wd[2][2][2];
#pragma unroll
        for (int rt = 0; rt < 2; ++rt)
#pragma unroll
            for (int kt = 0; kt < 2; ++kt) { f32x16 acc = zero16();
#pragma unroll
                for (int ks = 0; ks < 4; ++ks) if (rt == 1 || ks < 2) acc = MFMA32(rt ? Tw1[ks] : Tw0[ks], trfrag(Kimg, 16 * ks + 8 * hq, 16 * ks + 8 * hq + 4, kt, lane), acc);
                f32x16 neg;
#pragma unroll
                for (int i = 0; i < 16; ++i) neg[i] = -acc[i];
                Wn[rt][kt][0] = packacc(neg, 0); Wn[rt][kt][1] = packacc(neg, 1);
#pragma unroll
                for (int g4 = 0; g4 < 4; ++g4) { const f32x4 dl = *(const LAS f32x4*)(tb_dl + 32 * rt + 8 * g4 + 4 * hq);
#pragma unroll
                    for (int t = 0; t < 4; ++t) acc[4 * g4 + t] *= dl[t]; }
                Wd[rt][kt][0] = packacc(acc, 0); Wd[rt][kt][1] = packacc(acc, 1); }
#pragma unroll
        for (int kt = 0; kt < 2; ++kt)
#pragma unroll
            for (int it = 0; it < 2; ++it) { const int i_ = 32 * it + r32; const bool ok = i_ < nvalid; const float gam = ok ? __expf(tb_gc[i_]) : 0.f;
                const bf16* qp = QKV + (row0 + (ok ? i_ : 0)) * BQKV + qc + 32 * kt + 4 * hq; f32x16 acc;
#pragma unroll
                for (int g4 = 0; g4 < 4; ++g4) { const u32x2 qv = *(const GAS u32x2*)(qp + 8 * g4);
                    acc[4 * g4] = __uint_as_float(qv.x << 16) * gam; acc[4 * g4 + 1] = __uint_as_float(qv.x & 0xffff0000u) * gam;
                    acc[4 * g4 + 2] = __uint_as_float(qv.y << 16) * gam; acc[4 * g4 + 3] = __uint_as_float(qv.y & 0xffff0000u) * gam; }
#pragma unroll
                for (int jt = 0; jt <= it; ++jt)
#pragma unroll
                    for (int s = 0; s < 2; ++s) acc = MFMA32(Wn[jt][kt][s], Xp[jt + it][s], acc);
#pragma unroll
                for (int g4 = 0; g4 < 4; ++g4) { u32x2 o; o.x = cvtpk(acc[4 * g4], acc[4 * g4 + 1]); o.y = cvtpk(acc[4 * g4 + 2], acc[4 * g4 + 3]);
                    *(GAS u32x2*)(gAo + (i_ * 64 + pfun4(32 * kt + 8 * g4 + 4 * hq)) * 2) = o; } }
#pragma unroll
        for (int kt = 0; kt < 2; ++kt)
#pragma unroll
            for (int k2 = 0; k2 < 2; ++k2) { f32x16 acc = zero16();
#pragma unroll
                for (int lt = 0; lt < 2; ++lt)
#pragma unroll
                    for (int s = 0; s < 2; ++s) acc = MFMA32(Wd[lt][kt][s], trfrag(Kimg, 32 * lt + 16 * s + 4 * hq, 32 * lt + 16 * s + 8 + 4 * hq, k2, lane), acc);
#pragma unroll
                for (int g4 = 0; g4 < 4; ++g4) { u32x2 o; o.x = cvtpk(-acc[4 * g4], -acc[4 * g4 + 1]); o.y = cvtpk(-acc[4 * g4 + 2], -acc[4 * g4 + 3]);
                    *(GAS u32x2*)(gBs + ((32 * k2 + r32) * 64 + pfun4(32 * kt + 8 * g4 + 4 * hq)) * 2) = o; } }
    }
    asm volatile("s_waitcnt lgkmcnt(0)" ::: "memory");
}
DI void p_gdn_prep(Frame& F, const CAS Args& A, int l) {
    LAS unsigned char* pw = F.lds + F.wave * PW_BYTES;
    const int gw = F.vcu * NWAVES + F.wave, NGW = F.G * NWAVES;
    for (int u = gw; u < GD_UNITS; u += NGW) {
        int uid, h, nvalid; size_t row0;
        if (u < BATCH * BH * (SEQ / CHUNK)) { const int c = u >> 5, sq = u & 31, b = sq >> 3; h = sq & 7; uid = sq * (SEQ / CHUNK) + c; row0 = (size_t)b * SEQ + c * CHUNK; nvalid = 64; }
        else { const int sq = u - BATCH * BH * (SEQ / CHUNK), b = sq >> 3; h = sq & 7; uid = BATCH * BH * (SEQ / CHUNK) + sq; row0 = (size_t)MP + b * DECS; nvalid = DECS; }
        int lane_o = F.lane; asm volatile("" : "+v"(lane_o));
        gdn_prep_unit(A, l, pw, lane_o, uid, row0, nvalid, h);
    }
}

struct ScanRegs { bf16x8 bs[4][2], ao[4][2]; u32x2 cs[4], co[4]; float e; };
DI void scan_load(ScanRegs& R, const unsigned char* ws, int uid, int lane, int w4) {
    const int r16 = lane & 15, q = lane >> 4;
    const unsigned char* pb = ws + WS_GBS + (size_t)uid * 8192; const unsigned char* pa = ws + WS_GAO + (size_t)uid * 8192;
    const unsigned char* pcs = ws + WS_GCS + (size_t)uid * 8192 + ((16 * w4 + r16) * 64 + 4 * q) * 2; const unsigned char* pco = ws + WS_GCO + (size_t)uid * 8192 + ((16 * w4 + r16) * 64 + 4 * q) * 2;
#pragma unroll
    for (int mt = 0; mt < 4; ++mt) {
#pragma unroll
        for (int s = 0; s < 2; ++s) { R.bs[mt][s] = *(const GAS bf16x8*)(pb + ((16 * mt + r16) * 64 + 32 * s + 8 * q) * 2); R.ao[mt][s] = *(const GAS bf16x8*)(pa + ((16 * mt + r16) * 64 + 32 * s + 8 * q) * 2); }
        R.cs[mt] = *(const GAS u32x2*)(pcs + 32 * mt); R.co[mt] = *(const GAS u32x2*)(pco + 32 * mt);
    }
    R.e = ((const float*)(ws + WS_GE))[uid];
}
DI void scan_step(const ScanRegs& R, f32x4 (&S)[4], bf16* orow, LAS float* xb, const float nwv, int lane, int w4, int nmt) {
    const int r16 = lane & 15, q = lane >> 4;
    unsigned short z[16];
#pragma unroll
    for (int mt = 0; mt < 4; ++mt)
#pragma unroll
        for (int i = 0; i < 4; ++i) z[4 * mt + i] = (mt < nmt) ? orow[(size_t)(16 * mt + 4 * q + i) * 1024] : (unsigned short)0;
    bf16x8 Sb[2];
#pragma unroll
    for (int s = 0; s < 2; ++s) { v4u w; w.x = cvtpk(S[2 * s][0], S[2 * s][1]); w.y = cvtpk(S[2 * s][2], S[2 * s][3]); w.z = cvtpk(S[2 * s + 1][0], S[2 * s + 1][1]); w.w = cvtpk(S[2 * s + 1][2], S[2 * s + 1][3]); Sb[s] = __builtin_bit_cast(bf16x8, w); }
    f32x4 o[4];
#pragma unroll
    for (int mt = 0; mt < 4; ++mt) {
        f32x4 cs, co;
        cs[0] = __uint_as_float(R.cs[mt].x << 16); cs[1] = __uint_as_float(R.cs[mt].x & 0xffff0000u); cs[2] = __uint_as_float(R.cs[mt].y << 16); cs[3] = __uint_as_float(R.cs[mt].y & 0xffff0000u);
        co[0] = __uint_as_float(R.co[mt].x << 16); co[1] = __uint_as_float(R.co[mt].x & 0xffff0000u); co[2] = __uint_as_float(R.co[mt].y << 16); co[3] = __uint_as_float(R.co[mt].y & 0xffff0000u);
        f32x4 as = S[mt] * R.e + cs;
#pragma unroll
        for (int s = 0; s < 2; ++s) { as = __builtin_amdgcn_mfma_f32_16x16x32_bf16(R.bs[mt][s], Sb[s], as, 0, 0, 0); co = __builtin_amdgcn_mfma_f32_16x16x32_bf16(R.ao[mt][s], Sb[s], co, 0, 0, 0); }
        S[mt] = as; o[mt] = co;
    }
#pragma unroll
    for (int mt = 0; mt < 4; ++mt) { f32x4 sq = o[mt] * o[mt];
#pragma unroll
        for (int i = 0; i < 4; ++i) { float v = sq[i]; v += __shfl_xor(v, 1); v += __shfl_xor(v, 2); v += __shfl_xor(v, 4); v += __shfl_xor(v, 8); sq[i] = v; }
        if (r16 == 0) *(LAS f32x4*)(xb + w4 * 64 + 16 * mt + 4 * q) = sq; }
    __syncthreads();
#pragma unroll
    for (int mt = 0; mt < 4; ++mt) {
        if (mt < nmt) {
            f32x4 tot = *(const LAS f32x4*)(xb + 16 * mt + 4 * q) + *(const LAS f32x4*)(xb + 64 + 16 * mt + 4 * q) + *(const LAS f32x4*)(xb + 128 + 16 * mt + 4 * q) + *(const LAS f32x4*)(xb + 192 + 16 * mt + 4 * q);
#pragma unroll
            for (int i = 0; i < 4; ++i) { const float rs = 1.0f / sqrtf(tot[i] * (1.f / 64.f) + NORM_EPS);
                orow[(size_t)(16 * mt + 4 * q + i) * 1024] = (bf16)f2bf(o[mt][i] * rs * nwv * bf2f(z[4 * mt + i])); }
        }
    }
}
DI void p_gdn_scan(Frame& F, const CAS Args& A, int l) {
    unsigned char* ws = A.ws;
    if (F.vcu >= 16 + (DECB * BH) / 2) return;
    const bool prompt = F.vcu < 16; const int sq = (prompt ? 2 * F.vcu : 2 * (F.vcu - 16)) + (F.wave >> 2), w4 = F.wave & 3;
    const int b = sq >> 3, h = sq & 7, nch = prompt ? SEQ / CHUNK : 1, nmt = prompt ? 4 : 2;
    const int lane = F.lane, r16 = lane & 15, q = lane >> 4;
    const size_t rowbase = prompt ? (size_t)b * SEQ : (size_t)MP + b * DECS;
    const int uid0 = prompt ? sq * (SEQ / CHUNK) : BATCH * BH * (SEQ / CHUNK) + sq;
    bf16* ob = (bf16*)(ws + WS_OAB) + rowbase * 1024 + 512 + h * 64 + 16 * w4 + r16;
    f32x4 S[4];
#pragma unroll
    for (int mt = 0; mt < 4; ++mt) S[mt] = (f32x4){0.f, 0.f, 0.f, 0.f};
    if (!prompt) { const float* s0 = A.in[I_SG] + ((size_t)(l * DECB + b) * BH + h) * 4096 + 16 * w4 + r16;
#pragma unroll
        for (int mt = 0; mt < 4; ++mt)
#pragma unroll
            for (int i = 0; i < 4; ++i) S[mt][i] = s0[(16 * mt + 4 * q + i) * 64]; }
    const float nwv = A.in[I_GNW][l * 64 + 16 * w4 + r16];
    LAS float* xb0 = (LAS float*)(F.lds + (F.wave >> 2) * 4096);
    ScanRegs Ra;
    for (int c = 0; c < nch; ++c) {
        scan_load(Ra, ws, uid0 + c, lane, w4);
        scan_step(Ra, S, ob + (size_t)c * 64 * 1024, xb0 + (c & 1) * 256, nwv, lane, w4, nmt);
    }
    float* so = A.out + (prompt ? O_GP + ((size_t)(l * BATCH + b) * BH + h) * 4096 : O_GS + ((size_t)(l * DECB + b) * BH + h) * 4096) + 16 * w4 + r16;
#pragma unroll
    for (int mt = 0; mt < 4; ++mt)
#pragma unroll
        for (int i = 0; i < 4; ++i) so[(16 * mt + 4 * q + i) * 64] = S[mt][i];
}
DI void p_inproj(Frame& F, const CAS Args& A, int l) {
    unsigned char* ws = A.ws;
    pg8::Gemm g{(const pg8::bf16_t*)(ws + WS_HB), (const pg8::bf16_t*)(ws + WS_WIN) + (size_t)l * NIN * D, M, NIN, D};
    pg8::StaticOrder S; S.init(M, NIN, F.G, F.bx);
    pg8::EpiInProj E{ws, A.out, A.in[I_ALOG] + l * 8, A.in[I_DTB] + l * 8, l};
    pg8::gemm_phase<pg8::EpiInProj, pg8::StaticOrder, true, true>(F.lds + RING_OFF, g, S, E, F.tid);
}
DI void p_mix(Frame& F, const CAS Args& A, int l) {
    unsigned char* ws = A.ws;
    pg8::Gemm g{(const pg8::bf16_t*)(ws + WS_OAB), (const pg8::bf16_t*)(ws + WS_WAB) + (size_t)l * D * 1024, M, D, 1024};
    pg8::StaticOrder S; S.init(M, D, F.G, F.bx);
    pg8::EpiMix E{ws};
    pg8::gemm_phase<pg8::EpiMix, pg8::StaticOrder, true, true>(F.lds + RING_OFF, g, S, E, F.tid);
}
DI void p_outproj(Frame& F, const CAS Args& A, int l) {
    unsigned char* ws = A.ws;
    pg8::Gemm g{(const pg8::bf16_t*)(ws + WS_MIX), (const pg8::bf16_t*)(ws + WS_WO) + (size_t)l * D * D, M, D, D};
    pg8::StaticOrder S; S.init(M, D, F.G, F.bx);
    pg8::EpiResid E{A.out + O_Y, (float*)(ws + WS_Z)};
    pg8::gemm_phase<pg8::EpiResid, pg8::StaticOrder, true, true>(F.lds + RING_OFF, g, S, E, F.tid);
}
DI void p_ln(Frame& F, const CAS Args& A, int l) {
    unsigned char* ws = A.ws;
    const float* Z = (const float*)(ws + WS_Z); float* H = A.out + O_Y; bf16* HB = (bf16*)(ws + WS_HB);
    const int gw = F.vcu * NWAVES + F.wave, NGW = F.G * NWAVES;
    for (int m = gw; m < M; m += NGW) ln_row(Z + (size_t)m * D, A.in[I_LNG] + (size_t)l * D, A.in[I_LNB] + (size_t)l * D, H + (size_t)m * D, HB + (size_t)m * D, F.lane);
}

#ifndef PH_MASK
#define PH_MASK 0xff
#endif
constexpr int PH_PER_LAYER = 7, N_PHASES = 1 + DEPTH * PH_PER_LAYER;
template <int PMASK> __global__ void __launch_bounds__(NWAVES * 64, 2) trunk_fwd(Args args_) {
    const Args& args = args_;
    extern __shared__ __attribute__((aligned(16))) unsigned char lds[];
    LAS unsigned char* const ldsb = (LAS unsigned char*)lds;
    for (int u = threadIdx.x; u < (BIAS_OFF - LDSCTL_OFF) / 4; u += NWAVES * 64) ((LAS unsigned*)(ldsb + LDSCTL_OFF))[u] = 0u;
    __syncthreads();
    const int lo = args.ph_lo, hi = args.ph_hi;
    const int wave_s = __builtin_amdgcn_readfirstlane(threadIdx.x >> 6);
    if (hi - lo > 1) (void)xcd_barrier_post((unsigned*)((gu32*)(args.ws + WS_CTL) + CW_BAR), (volatile LAS unsigned*)(ldsb + MISC_OFF) + 8);
#define PH_BEGIN(k) if (lo <= (k) && (k) < hi) { \
        const CAS Args* kp = (const CAS Args*)__builtin_amdgcn_kernarg_segment_ptr(); asm volatile("" : "+s"(kp)); const CAS Args& A_ = *kp; \
        int tid = wave_s * 64 + (int)__builtin_amdgcn_mbcnt_hi(~0u, __builtin_amdgcn_mbcnt_lo(~0u, 0u)), bx = blockIdx.x; asm volatile("" : "+v"(tid)); asm volatile("" : "+s"(bx)); \
        Frame F; F.lds = ldsb; F.MISC = (volatile LAS unsigned*)(ldsb + MISC_OFF); F.tid = tid; F.lane = tid & 63; F.wave = __builtin_amdgcn_readfirstlane(tid >> 6); \
        F.G = gridDim.x; F.vcu = (F.G % 8 == 0) ? (bx % 8) * (F.G / 8) + bx / 8 : bx; F.bx = bx; F.ctl = (gu32*)(A_.ws + WS_CTL);
#define PH_END(k) if ((k) + 1 < hi) { XcdBarrier bar; bar.bar = (unsigned*)((gu32*)(A_.ws + WS_CTL) + CW_BAR); bar.x = xb_xcc_id(); bar.st = (volatile LAS unsigned*)(ldsb + MISC_OFF) + 8; xcd_barrier(bar, F.tid == 0); } }
#define RUN_LAYER(l) \
    PH_BEGIN(1 + 7 * (l) + 0) if constexpr ((PMASK & 2) != 0) p_inproj(F, A_, (l)); PH_END(1 + 7 * (l) + 0) \
    PH_BEGIN(1 + 7 * (l) + 1) if constexpr ((PMASK & 4) != 0) { p_conv(F, A_, (l)); p_attention(F, A_, (l)); } PH_END(1 + 7 * (l) + 1) \
    PH_BEGIN(1 + 7 * (l) + 2) if constexpr ((PMASK & 8) != 0) p_gdn_prep(F, A_, (l)); PH_END(1 + 7 * (l) + 2) \
    PH_BEGIN(1 + 7 * (l) + 3) if constexpr ((PMASK & 16) != 0) p_gdn_scan(F, A_, (l)); PH_END(1 + 7 * (l) + 3) \
    PH_BEGIN(1 + 7 * (l) + 4) if constexpr ((PMASK & 32) != 0) p_mix(F, A_, (l)); PH_END(1 + 7 * (l) + 4) \
    PH_BEGIN(1 + 7 * (l) + 5) if constexpr ((PMASK & 64) != 0) p_outproj(F, A_, (l)); PH_END(1 + 7 * (l) + 5) \
    PH_BEGIN(1 + 7 * (l) + 6) if constexpr ((PMASK & 128) != 0) p_ln(F, A_, (l)); PH_END(1 + 7 * (l) + 6)
    PH_BEGIN(0) if constexpr ((PMASK & 1) != 0) p0_prologue(F, A_); PH_END(0)
    RUN_LAYER(0)
    RUN_LAYER(1)
#undef PH_BEGIN
#undef PH_END
#undef RUN_LAYER
}

extern "C" void kernel_launch(void* const* d_in, const int* in_sizes, int n_in, void* d_out, int out_size, void* d_ws, size_t ws_size, hipStream_t stream) {
    static int grid = 0;
    if (grid == 0) {
        if (n_in != 19 || in_sizes[0] != MP * D || (size_t)out_size != O_END || ws_size < WS_END) {
            fprintf(stderr, "kernel_launch: unexpected shapes: n_in %d in0 %d out %d ws %zu (need %zu); nothing launched\n", n_in, n_in > 0 ? in_sizes[0] : -1, out_size, ws_size, (size_t)WS_END); grid = -1; return; }
        int dev = 0, cus = 0, per_cu = 0;
        if (hipGetDevice(&dev) != hipSuccess || hipDeviceGetAttribute(&cus, hipDeviceAttributeMultiprocessorCount, dev) != hipSuccess) { grid = -1; return; }
        bool okattr = true;
#define SETATTR(MK) okattr = okattr && (hipFuncSetAttribute((const void*)trunk_fwd<MK>, hipFuncAttributeMaxDynamicSharedMemorySize, LDS_BYTES) == hipSuccess)
#if MK_PER_PHASE
        SETATTR(1); SETATTR(2); SETATTR(4); SETATTR(8); SETATTR(16); SETATTR(32); SETATTR(64); SETATTR(128);
#else
        SETATTR(0xff);
#endif
        if (!okattr) { fprintf(stderr, "kernel_launch: hipFuncSetAttribute failed\n"); grid = -1; return; }
        (void)per_cu; (void)hipGetLastError();
        grid = cus;
    }
    if (grid < 0) return;
    if (hipMemsetAsync((char*)d_ws + WS_CTL, 0, CTL_ZERO_BYTES, stream) != hipSuccess) return;
    Args a{};
    for (int i = 0; i < 19; ++i) a.in[i] = (const float*)d_in[i];
    a.out = (float*)d_out; a.ws = (unsigned char*)d_ws;
#if MK_PER_PHASE
    for (int ph = 0; ph < N_PHASES; ++ph) {
        const int s = ph == 0 ? -1 : (ph - 1) % PH_PER_LAYER;
        a.ph_lo = ph; a.ph_hi = ph + 1; a.li = 0;
        const dim3 g(grid), b(NWAVES * 64);
        if (s == -1) hipLaunchKernelGGL(trunk_fwd<1>, g, b, LDS_BYTES, stream, a);
        else if (s == 0) hipLaunchKernelGGL(trunk_fwd<2>, g, b, LDS_BYTES, stream, a);
        else if (s == 1) hipLaunchKernelGGL(trunk_fwd<4>, g, b, LDS_BYTES, stream, a);
        else if (s == 2) hipLaunchKernelGGL(trunk_fwd<8>, g, b, LDS_BYTES, stream, a);
        else if (s == 3) hipLaunchKernelGGL(trunk_fwd<16>, g, b, LDS_BYTES, stream, a);
        else if (s == 4) hipLaunchKernelGGL(trunk_fwd<32>, g, b, LDS_BYTES, stream, a);
        else if (s == 5) hipLaunchKernelGGL(trunk_fwd<64>, g, b, LDS_BYTES, stream, a);
        else hipLaunchKernelGGL(trunk_fwd<128>, g, b, LDS_BYTES, stream, a);
    }
#else
    a.ph_lo = 0; a.ph_hi = N_PHASES; a.li = 0;
    hipLaunchKernelGGL(trunk_fwd<0xff>, dim3(grid), dim3(NWAVES * 64), LDS_BYTES, stream, a);
#endif
}
```

```cpp
#include <hip/hip_runtime.h>
#include <cstdio>
#include <cstdint>

#ifndef MK_PER_PHASE
#define MK_PER_PHASE 0
#endif

constexpr int D = 1024, BATCH = 4, SEQ = 8192, DEPTH = 2, DECB = 32, DECS = 32, PAST = 4096;
constexpr int MP = BATCH * SEQ, MS = DECB * DECS, M = MP + MS;
constexpr int CHUNK = 64, ATTW = 512, AH = 8, AD = 64, AW = 512, NREL = 192, RELMAX = 128;
constexpr int BH = 8, BD = 64, BW = 512, BQKV = 1536;
constexpr int IN_DIM = 6160, NIN = 6400;
constexpr float LN_EPS = 1e-5f, NORM_EPS = 1e-6f;
constexpr float ALPHA = 1.41421356237309515f;
constexpr float LOG2E = 1.4426950408889634f;
constexpr float QSCALE = 0.125f * LOG2E;

constexpr size_t O_Y = 0;
constexpr size_t O_KP = (size_t)M * D;
constexpr size_t O_VP = O_KP + (size_t)DEPTH * BATCH * ATTW * AW;
constexpr size_t O_CP = O_VP + (size_t)DEPTH * BATCH * ATTW * AW;
constexpr size_t O_GP = O_CP + (size_t)DEPTH * BATCH * 3 * BQKV;
constexpr size_t O_KS = O_GP + (size_t)DEPTH * BATCH * BH * BD * BD;
constexpr size_t O_VS = O_KS + (size_t)DEPTH * DECB * DECS * AW;
constexpr size_t O_CS = O_VS + (size_t)DEPTH * DECB * DECS * AW;
constexpr size_t O_GS = O_CS + (size_t)DEPTH * DECB * 3 * BQKV;
constexpr size_t O_END = O_GS + (size_t)DEPTH * DECB * BH * BD * BD;
static_assert(O_END == 43585536, "output size");

constexpr size_t MiB = 1u << 20;
constexpr size_t WS_CTL = 0, CTL_ZERO_BYTES = 1 * MiB;
constexpr size_t WS_WIN = 1 * MiB;
constexpr size_t WS_WAB = 26 * MiB;
constexpr size_t WS_WO = 30 * MiB;
constexpr size_t WS_G = 34 * MiB;
constexpr size_t WS_BETA = WS_G + (size_t)M * 8 * 4;
constexpr size_t WS_HB = 37 * MiB;
constexpr size_t WS_KA = 103 * MiB, WS_VA = 136 * MiB, WS_SZA = 169 * MiB;
constexpr size_t WS_OAB = 202 * MiB;
constexpr size_t WS_XB = 268 * MiB;
constexpr size_t WS_GA = 367 * MiB, WS_GB = 433 * MiB;
constexpr size_t WS_HALO = 499 * MiB;
constexpr size_t WS_END = 504 * MiB;
constexpr size_t WS_MIX = WS_HB;
constexpr size_t WS_Z = WS_GA;
constexpr int GD_UNITS = BATCH * BH * (SEQ / CHUNK) + DECB * BH;
constexpr size_t GD_MAT = (size_t)GD_UNITS * 8192;
constexpr size_t WS_GAO = 37 * MiB, WS_GBS = WS_GAO + GD_MAT, WS_GCO = WS_GBS + GD_MAT, WS_GCS = WS_GCO + GD_MAT, WS_GE = WS_GCS + GD_MAT;
static_assert(WS_GE + (size_t)GD_UNITS * 4 <= WS_OAB, "delta-rule operators overlay");
static_assert(WS_HALO + (size_t)(MP / 64) * 3 * BQKV * 2 <= WS_END, "halo");
static_assert(WS_BETA + (size_t)M * 8 * 4 <= WS_HB && WS_HB + (size_t)M * D * 2 <= WS_KA && WS_SZA + (size_t)M * 512 * 2 <= WS_OAB, "ws map");
static_assert(WS_OAB + (size_t)M * D * 2 <= WS_XB && WS_XB + (size_t)M * BQKV * 2 <= WS_GA && WS_GB + (size_t)M * D * 2 <= WS_HALO, "ws map 2");
static_assert(WS_Z + (size_t)M * D * 4 <= WS_HALO, "ws map 3");
constexpr int CW_TMO = 0, CW_CODE = 1, CW_BAR = 4096;

constexpr int RING_OFF = 0, RING_BYTES = 131072;
constexpr int PW_BYTES = 18432;
constexpr int LDSCTL_OFF = 8 * PW_BYTES, MISC_OFF = LDSCTL_OFF + 320;
constexpr int BIAS_OFF = LDSCTL_OFF + 1024;
constexpr int LDS_BYTES = 163840;
static_assert(BIAS_OFF + AH * NREL * 4 <= LDS_BYTES && MISC_OFF + 128 <= BIAS_OFF && RING_BYTES <= LDSCTL_OFF, "LDS map");
constexpr int NWAVES = 8;

namespace pg8 {
#define PG8_LAS __attribute__((address_space(3)))
typedef unsigned short bf16_t;
typedef short bf16x8 __attribute__((ext_vector_type(8)));
typedef float f32x4 __attribute__((ext_vector_type(4)));
typedef unsigned u32x4 __attribute__((ext_vector_type(4)));
constexpr int BM = 256, BK = 64, HALF = 128, HTB = HALF * BK * 2  , STAGE_BYTES = 8 * HTB, NXCD = 8, WGM = 8;

__host__ __device__ __forceinline__ int lds_byte(int r, int c) { const int st = (r >> 4) * 2 + (c >> 5), rr = r & 15, cc = c & 31, ob = rr * 64 + cc * 2; return st * 1024 + (ob ^ (((ob >> 9) & 1) << 5)); }
__host__ __device__ __forceinline__ void stage_rc(int b, int& R, int& C) { const int st = b / 1024, sb = b % 1024, swz = sb ^ (((sb >> 9) & 1) << 5); R = (st >> 1) * 16 + swz / 64; C = (st & 1) * 32 + (swz % 64) / 2; }
__host__ __device__ __forceinline__ int perm32(int rho) { const int n = rho >> 4, i = rho & 15; return 8 * (i >> 2) + 4 * n + (i & 3); }

struct Unit { int pm, pn; };
struct Gemm { const bf16_t* A; const bf16_t* Bt; int M, N, K; };

struct StaticOrder {
    int nM, nN, nwg, G, c;
    __host__ __device__ void init(int M, int N, int G_, int c_) { nM = M / BM; nN = N / BM; nwg = nM * nN; G = G_; c = c_; }
    __host__ __device__ bool next(int i, Unit& u) const {
        const long L = (long)i * G + c; if (L >= nwg) return false;
        int wgid = (int)L; { const int q = nwg / NXCD, r = nwg % NXCD, xcd = wgid % NXCD, off = wgid / NXCD; wgid = (xcd < r ? xcd * (q + 1) : r * (q + 1) + (xcd - r) * q) + off; }
        const int nig = WGM * nN, gid = wgid / nig, fm = gid * WGM, gsz = (nM - fm) < WGM ? (nM - fm) : WGM;
        u.pm = fm + ((wgid % nig) % gsz); u.pn = (wgid % nig) / gsz; return true;
    }
    __device__ __forceinline__ void a_ready(const Unit&) const {}
    __device__ __forceinline__ void done(const Unit&) const {}
};


__device__ __forceinline__ unsigned cvt_pk_bf16(float lo, float hi) { unsigned r; asm volatile("v_cvt_pk_bf16_f32 %0, %1, %2" : "=v"(r) : "v"(lo), "v"(hi)); return r; }
__device__ __forceinline__ float bf_lo(unsigned w) { return __uint_as_float(w << 16); }
__device__ __forceinline__ float bf_hi(unsigned w) { return __uint_as_float(w & 0xffff0000u); }
__device__ __forceinline__ float sigmoid_f(float x) { return __builtin_amdgcn_rcpf(1.0f + __expf(-x)); }
__device__ __forceinline__ float silu_f(float x) { return x * sigmoid_f(x); }
__device__ __forceinline__ u32x4 pack8(const f32x4& a, const f32x4& b) { u32x4 w; w.x = cvt_pk_bf16(a[0], a[1]); w.y = cvt_pk_bf16(a[2], a[3]); w.z = cvt_pk_bf16(b[0], b[1]); w.w = cvt_pk_bf16(b[2], b[3]); return w; }

template <int ACT  > __device__ __forceinline__ void epi_store_bf16(const f32x4 (&acc)[2][2][4][2], unsigned char* base, unsigned off0, unsigned ldb  , float scale) {
#pragma unroll
    for (int ai = 0; ai < 2; ++ai)
#pragma unroll
        for (int m = 0; m < 4; ++m) {
#pragma unroll
            for (int bj = 0; bj < 2; ++bj) {
                f32x4 v0 = acc[ai][bj][m][0], v1 = acc[ai][bj][m][1];
                if (ACT == 0) { v0 = v0 * scale; v1 = v1 * scale; }
                if (ACT == 1) {
#pragma unroll
                    for (int j = 0; j < 4; ++j) { v0[j] = silu_f(v0[j]); v1[j] = silu_f(v1[j]); } }
                if (ACT == 2) {
#pragma unroll
                    for (int j = 0; j < 4; ++j) { v0[j] = sigmoid_f(v0[j]); v1[j] = sigmoid_f(v1[j]); } }
                *(u32x4*)(base + (off0 + (unsigned)(ai * HALF + m * 16) * ldb + (unsigned)(bj * HALF * 2))) = pack8(v0, v1);
            }
            asm volatile("" ::: "memory");
        }
}
__device__ __forceinline__ void epi_store_f32_rows(const f32x4 (&acc)[2][2][4][2], unsigned char* base, unsigned off0, unsigned ldb, int rt0, int r_lo, int r_hi) {
#pragma unroll
    for (int ai = 0; ai < 2; ++ai)
#pragma unroll
        for (int m = 0; m < 4; ++m) {
            const int rt = rt0 + ai * HALF + m * 16;
            if (rt >= r_lo && rt < r_hi) {
#pragma unroll
                for (int bj = 0; bj < 2; ++bj) {
                    unsigned char* p = base + (off0 + (unsigned)(ai * HALF + m * 16) * ldb + (unsigned)(bj * HALF * 4));
                    *(f32x4*)p = acc[ai][bj][m][0]; *(f32x4*)(p + 16) = acc[ai][bj][m][1];
                }
            }
            asm volatile("" ::: "memory");
        }
}
struct EpiInProj {
    static constexpr bool PERM = true, AFTER_DRAIN = false; static constexpr int MIDK = 0;
    unsigned char* ws; float* out; const float* a_log; const float* dt_bias; int l;
    __device__ __forceinline__ void operator()(const f32x4 (&acc)[2][2][4][2], const Unit& u, int wr, int wc, int fr, int fq) const {
        const int pn = u.pn, pm = u.pm;
        const int rt0 = wr * 64 + fr;
        const int ct0 = wc * 32 + 8 * fq;
        const unsigned row0 = (unsigned)pm * BM + rt0;
        if (pn < 2) {
            epi_store_bf16<0>(acc, ws + WS_OAB, (row0 * 1024u + pn * 256 + ct0) * 2u, 2048u, QSCALE);
        } else if (pn < 6) {
            const int isv = (pn >= 4); const unsigned col = (unsigned)(pn - (isv ? 4 : 2)) * 256 + ct0;
            epi_store_bf16<0>(acc, ws + (isv ? WS_VA : WS_KA), (row0 * 512u + col) * 2u, 1024u, 1.0f);
            if (pm >= 128) {
                unsigned char* ob = (unsigned char*)(out + (isv ? O_VS : O_KS) + (size_t)l * DECB * DECS * AW);
                epi_store_f32_rows(acc, ob, ((row0 - MP) * 512u + col) * 4u, 2048u, rt0, 0, 256);
            } else if ((pm & 31) >= 30) {
                unsigned char* ob = (unsigned char*)(out + (isv ? O_VP : O_KP) + (size_t)l * BATCH * ATTW * AW);
                epi_store_f32_rows(acc, ob, ((((unsigned)(pm >> 5) * ATTW + ((pm & 31) - 30) * 256 + rt0) * 512u) + col) * 4u, 2048u, rt0, 0, 256);
            }
        } else if (pn < 8) {
            epi_store_bf16<1>(acc, ws + WS_SZA, (row0 * 512u + (pn - 6) * 256 + ct0) * 2u, 1024u, 1.0f);
        } else if (pn < 14) {
            const unsigned col = (unsigned)(pn - 8) * 256 + ct0;
            epi_store_bf16<0>(acc, ws + WS_XB, (row0 * (unsigned)BQKV + col) * 2u, BQKV * 2u, 1.0f);
            if (pm >= 128) {
                float* oCs = out + O_CS + (size_t)l * DECB * 3 * BQKV;
#pragma unroll
                for (int ai = 0; ai < 2; ++ai)
#pragma unroll
                    for (int m = 0; m < 4; ++m) { const int rs = (int)(row0 - MP) + ai * HALF + m * 16, t = rs & 31;
                        if (t >= 29) {
#pragma unroll
                            for (int bj = 0; bj < 2; ++bj) { float* o = oCs + ((size_t)(rs >> 5) * 3 + (t - 29)) * BQKV + col + bj * HALF; *(f32x4*)o = acc[ai][bj][m][0]; *(f32x4*)(o + 4) = acc[ai][bj][m][1]; } }
                        asm volatile("" ::: "memory"); }
            } else {
#pragma unroll
                for (int ai = 0; ai < 2; ++ai)
#pragma unroll
                    for (int m = 0; m < 4; ++m) { const int rr = (int)row0 + ai * HALF + m * 16, t = rr & 63;
                        if (t >= 61) {
#pragma unroll
                            for (int bj = 0; bj < 2; ++bj) *(u32x4*)(ws + WS_HALO + ((size_t)((rr >> 6) * 3 + (t - 61)) * BQKV + col + bj * HALF) * 2) = pack8(acc[ai][bj][m][0], acc[ai][bj][m][1]); }
                        asm volatile("" ::: "memory"); }
                if ((pm & 31) == 31) {
                    unsigned char* ob = (unsigned char*)(out + O_CP + (size_t)l * BATCH * 3 * BQKV);
                    epi_store_f32_rows(acc, ob, ((((unsigned)(pm >> 5) * 3 + (unsigned)(rt0 - 253)) * BQKV) + col) * 4u, BQKV * 4u, rt0, 253, 256);
                }
            }
        } else if (pn < 16) {
            epi_store_bf16<1>(acc, ws + WS_OAB, (row0 * 1024u + 512 + (pn - 14) * 256 + ct0) * 2u, 2048u, 1.0f);
        } else if (pn < 24) {
            epi_store_bf16<2>(acc, ws + (pn < 20 ? WS_GA : WS_GB), (row0 * 1024u + ((pn - 16) & 3) * 256 + ct0) * 2u, 2048u, 1.0f);
        } else {
            if (wc == 0 && fq < 2) {
                float* G = (float*)(ws + WS_G); float* BETA = (float*)(ws + WS_BETA);
#pragma unroll
                for (int ai = 0; ai < 2; ++ai)
#pragma unroll
                    for (int m = 0; m < 4; ++m) {
                        const size_t row = (size_t)row0 + ai * HALF + m * 16;
                        f32x4 v0 = acc[ai][0][m][0], v1 = acc[ai][0][m][1];
                        float* dst = (fq == 0 ? G : BETA) + row * 8;
                        *(f32x4*)dst = v0; *(f32x4*)(dst + 4) = v1;
                        asm volatile("" ::: "memory");
                    }
            }
        }
    }
};

struct EpiMix {
    static constexpr bool PERM = true, AFTER_DRAIN = false; static constexpr int MIDK = 8;
    unsigned char* ws;
    __device__ __forceinline__ void mid(f32x4 (&acc)[2][2][4][2], const Unit& u, int wr, int wc, int fr, int fq) const {
        unsigned off0 = (((unsigned)u.pm * BM + wr * 64 + fr) * 1024u + u.pn * BM + wc * 32 + 8 * fq) * 2u;
        asm volatile("" : "+v"(off0));
        const unsigned char* GA = ws + WS_GA; const unsigned char* GB = ws + WS_GB;
#pragma unroll
        for (int ai = 0; ai < 2; ++ai)
#pragma unroll
            for (int m = 0; m < 4; ++m) {
#pragma unroll
                for (int bj = 0; bj < 2; ++bj) {
                    const unsigned off = off0 + (unsigned)(ai * HALF + m * 16) * 2048u + (unsigned)(bj * HALF * 2);
                    const u32x4 a = *(const u32x4*)(GA + off), b = *(const u32x4*)(GB + off);
                    f32x4 r0, r1;
                    r0[0] = bf_lo(a.x) * __builtin_amdgcn_rcpf(bf_lo(b.x)); r0[1] = bf_hi(a.x) * __builtin_amdgcn_rcpf(bf_hi(b.x));
                    r0[2] = bf_lo(a.y) * __builtin_amdgcn_rcpf(bf_lo(b.y)); r0[3] = bf_hi(a.y) * __builtin_amdgcn_rcpf(bf_hi(b.y));
                    r1[0] = bf_lo(a.z) * __builtin_amdgcn_rcpf(bf_lo(b.z)); r1[1] = bf_hi(a.z) * __builtin_amdgcn_rcpf(bf_hi(b.z));
                    r1[2] = bf_lo(a.w) * __builtin_amdgcn_rcpf(bf_lo(b.w)); r1[3] = bf_hi(a.w) * __builtin_amdgcn_rcpf(bf_hi(b.w));
                    acc[ai][bj][m][0] = acc[ai][bj][m][0] * r0; acc[ai][bj][m][1] = acc[ai][bj][m][1] * r1;
                }
                asm volatile("" ::: "memory");
            }
    }
    __device__ __forceinline__ void operator()(const f32x4 (&acc)[2][2][4][2], const Unit& u, int wr, int wc, int fr, int fq) const {
        const unsigned off0 = (((unsigned)u.pm * BM + wr * 64 + fr) * 1024u + u.pn * BM + wc * 32 + 8 * fq) * 2u;
        const unsigned char* GB = ws + WS_GB; unsigned char* MIX = ws + WS_MIX;
#pragma unroll
        for (int ai = 0; ai < 2; ++ai)
#pragma unroll
            for (int m = 0; m < 4; ++m) {
#pragma unroll
                for (int bj = 0; bj < 2; ++bj) {
                    const unsigned off = off0 + (unsigned)(ai * HALF + m * 16) * 2048u + (unsigned)(bj * HALF * 2);
                    const u32x4 b = *(const u32x4*)(GB + off);
                    f32x4 v0 = acc[ai][bj][m][0], v1 = acc[ai][bj][m][1];
                    v0[0] *= bf_lo(b.x); v0[1] *= bf_hi(b.x); v0[2] *= bf_lo(b.y); v0[3] *= bf_hi(b.y);
                    v1[0] *= bf_lo(b.z); v1[1] *= bf_hi(b.z); v1[2] *= bf_lo(b.w); v1[3] *= bf_hi(b.w);
                    *(u32x4*)(MIX + off) = pack8(v0, v1);
                }
                asm volatile("" ::: "memory");
            }
    }
};

struct EpiResid {
    static constexpr bool PERM = false, AFTER_DRAIN = false; static constexpr int MIDK = 0;
    const float* H; float* Z;
    __device__ __forceinline__ void operator()(const f32x4 (&acc)[2][2][4][2], const Unit& u, int wr, int wc, int fr, int fq) const {
        const int row0 = u.pm * BM + wr * 64 + fr, col0 = u.pn * BM + wc * 32 + 4 * fq;
#pragma unroll
        for (int ai = 0; ai < 2; ++ai)
#pragma unroll
            for (int m = 0; m < 4; ++m) { const size_t off = (size_t)(row0 + ai * HALF + m * 16) * D + col0;
#pragma unroll
                for (int bj = 0; bj < 2; ++bj)
#pragma unroll
                    for (int n = 0; n < 2; ++n) { const f32x4 h = *(const f32x4*)(H + off + bj * HALF + n * 16); *(f32x4*)(Z + off + bj * HALF + n * 16) = h * ALPHA + acc[ai][bj][m][n]; } }
    }
};

template <class Epi, class Sched, bool ALIGN_EPI = false, bool SP2 = false>
__device__ __forceinline__ void gemm_phase(PG8_LAS unsigned char* lds, const Gemm g, const Sched& S, const Epi& E, const int tid_in) {
    const int tid = tid_in, wid = __builtin_amdgcn_readfirstlane(tid >> 6), lane = tid & 63, wr = wid >> 2, wc = wid & 3, fr = lane & 15, fq = lane >> 4;
    const int K = g.K, nt = K / BK;
    unsigned voffA[2], voffB[2];
#pragma unroll
    for (int i = 0; i < 2; ++i) { int R, C; stage_rc(tid * 16 + i * 8192, R, C); const int Rb = Epi::PERM ? ((R & ~31) + perm32(R & 31)) : R;
        voffA[i] = (unsigned)(R * K + C) * 2u; voffB[i] = (unsigned)(Rb * K + C) * 2u; }
    const size_t kstep = (size_t)(BK * 2);
    const size_t hstep = (size_t)HALF * K * 2;
    const size_t tstep = 2 * hstep;
    const unsigned ldsw = (unsigned)wid * 1024u;
    const int aoff = lds_byte(wr * 64 + fr, fq * 8), boff = lds_byte(wc * 32 + fr, fq * 8);
#define PG8_SA(b, h) (((b) * 2 + (h)) * HTB)
#define PG8_SB(b, h) ((4 + (b) * 2 + (h)) * HTB)
#define PG8_STAGE(bufoff, gbase, voff) do { _Pragma("unroll") for (int _i = 0; _i < 2; ++_i) \
        __builtin_amdgcn_global_load_lds((const unsigned*)((const char*)(gbase) + (voff)[_i]), (PG8_LAS unsigned*)(lds + (bufoff) + ldsw + _i * 8192), 16, 0, 0); } while (0)
#define PG8_LDA(dst, b, h) do { _Pragma("unroll") for (int m = 0; m < 4; ++m) _Pragma("unroll") for (int k = 0; k < 2; ++k) dst[m][k] = *(const PG8_LAS bf16x8*)(lds + PG8_SA(b, h) + aoff + m * 2048 + k * 1024); } while (0)
#define PG8_LDB(dst, b, h) do { _Pragma("unroll") for (int n = 0; n < 2; ++n) _Pragma("unroll") for (int k = 0; k < 2; ++k) dst[n][k] = *(const PG8_LAS bf16x8*)(lds + PG8_SB(b, h) + boff + n * 2048 + k * 1024); } while (0)
#define PG8_MMA(ai, bj, At, Bt) do { __builtin_amdgcn_s_setprio(1); _Pragma("unroll") for (int m = 0; m < 4; ++m) _Pragma("unroll") for (int n = 0; n < 2; ++n) _Pragma("unroll") for (int k = 0; k < 2; ++k) \
        acc[ai][bj][m][n] = __builtin_amdgcn_mfma_f32_16x16x32_bf16(Bt[n][k], At[m][k], acc[ai][bj][m][n], 0, 0, 0); __builtin_amdgcn_s_setprio(0); } while (0)
#define PG8_WAIT_V(n) asm volatile("s_waitcnt vmcnt(" #n ")" ::: "memory")
#define PG8_WAIT_L(n) asm volatile("s_waitcnt lgkmcnt(" #n ")" ::: "memory")
#define PG8_BAR __builtin_amdgcn_s_barrier()
#define PG8_SCHED __builtin_amdgcn_sched_barrier(0)
    Unit cur, nxt; int ui = 0;
    if (!S.next(0, cur)) return;
    f32x4 acc[2][2][4][2];
#pragma unroll
    for (int a = 0; a < 2; ++a)
#pragma unroll
        for (int b = 0; b < 2; ++b)
#pragma unroll
            for (int m = 0; m < 4; ++m)
#pragma unroll
                for (int n = 0; n < 2; ++n) acc[a][b][m][n] = (f32x4){0.f, 0.f, 0.f, 0.f};
    bf16x8 At[4][2], B0[2][2], B1[2][2];
    const char* cA = (const char*)g.A + (size_t)cur.pm * tstep; const char* cB = (const char*)g.Bt + (size_t)cur.pn * tstep;
    S.a_ready(cur);
    if constexpr (SP2) {
        PG8_STAGE(PG8_SB(0, 0), cB, voffB); PG8_STAGE(PG8_SB(0, 1), cB + hstep, voffB); PG8_STAGE(PG8_SA(0, 0), cA, voffA); PG8_STAGE(PG8_SA(0, 1), cA + hstep, voffA);
        if (wr == 1) PG8_BAR;
        PG8_WAIT_V(2); PG8_BAR;
        PG8_STAGE(PG8_SB(1, 0), cB + kstep, voffB); PG8_STAGE(PG8_SA(1, 0), cA + kstep, voffA); PG8_STAGE(PG8_SB(1, 1), cB + hstep + kstep, voffB);
        PG8_WAIT_V(6); PG8_BAR;
    } else {
        PG8_STAGE(PG8_SB(0, 0), cB, voffB); PG8_STAGE(PG8_SA(0, 0), cA, voffA); PG8_STAGE(PG8_SB(0, 1), cB + hstep, voffB); PG8_STAGE(PG8_SA(0, 1), cA + hstep, voffA);
        if (wr == 1) PG8_BAR;
        PG8_WAIT_V(4); PG8_BAR;
        PG8_STAGE(PG8_SB(1, 0), cB + kstep, voffB); PG8_STAGE(PG8_SA(1, 0), cA + kstep, voffA); PG8_STAGE(PG8_SB(1, 1), cB + hstep + kstep, voffB);
        PG8_WAIT_V(6); PG8_BAR;
    }
    for (;;) {
        const bool has_next = S.next(ui + 1, nxt);
        const char* nA = has_next ? (const char*)g.A + (size_t)nxt.pm * tstep : cA; const char* nB = has_next ? (const char*)g.Bt + (size_t)nxt.pn * tstep : cB;
        for (int t = 0; t < nt; t += 2) {
            if constexpr (Epi::MIDK > 0) { if (t == Epi::MIDK) E.mid(acc, cur, wr, wc, fr, fq); }
            const bool last = (t == nt - 2);
            const char* a1 = cA + (size_t)(t + 1) * kstep;
            const char* a2 = last ? nA : cA + (size_t)(t + 2) * kstep; const char* b2 = last ? nB : cB + (size_t)(t + 2) * kstep;
            const char* a3 = a2 + kstep; const char* b3 = b2 + kstep;
            if (last && has_next) S.a_ready(nxt);
            if constexpr (SP2) {
            PG8_LDB(B0, 0, 0); PG8_LDB(B1, 0, 1); PG8_SCHED; PG8_LDA(At, 0, 0); PG8_STAGE(PG8_SA(1, 1), a1 + hstep, voffA);
            PG8_WAIT_V(8); PG8_WAIT_L(0); PG8_BAR; PG8_MMA(0, 0, At, B0); PG8_MMA(0, 1, At, B1); PG8_BAR; PG8_SCHED;
            PG8_LDA(At, 0, 1); PG8_STAGE(PG8_SB(0, 0), b2, voffB); PG8_STAGE(PG8_SB(0, 1), b2 + hstep, voffB); PG8_STAGE(PG8_SA(0, 0), a2, voffA);
            PG8_WAIT_V(8); PG8_WAIT_L(0); PG8_BAR; PG8_MMA(1, 0, At, B0); PG8_MMA(1, 1, At, B1); PG8_BAR; PG8_SCHED;
            PG8_LDB(B0, 1, 0); PG8_LDB(B1, 1, 1); PG8_SCHED; PG8_LDA(At, 1, 0); PG8_STAGE(PG8_SA(0, 1), a2 + hstep, voffA);
            PG8_WAIT_V(8); PG8_WAIT_L(0); PG8_BAR; PG8_MMA(0, 0, At, B0); PG8_MMA(0, 1, At, B1); PG8_BAR; PG8_SCHED;
            PG8_LDA(At, 1, 1); PG8_STAGE(PG8_SB(1, 0), b3, voffB); PG8_STAGE(PG8_SB(1, 1), b3 + hstep, voffB); PG8_STAGE(PG8_SA(1, 0), a3, voffA);
            PG8_WAIT_V(8); PG8_WAIT_L(0); PG8_BAR; PG8_MMA(1, 0, At, B0); PG8_MMA(1, 1, At, B1); PG8_BAR; PG8_SCHED;
            } else {
            PG8_LDB(B0, 0, 0); PG8_SCHED; PG8_LDA(At, 0, 0); PG8_STAGE(PG8_SA(1, 1), a1 + hstep, voffA);
            PG8_WAIT_L(8); PG8_BAR; PG8_WAIT_L(0); PG8_MMA(0, 0, At, B0); PG8_BAR; PG8_SCHED;
            PG8_LDB(B1, 0, 1); PG8_STAGE(PG8_SB(0, 0), b2, voffB);
            PG8_BAR; PG8_WAIT_L(0); PG8_MMA(0, 1, At, B1); PG8_BAR;
            PG8_LDA(At, 0, 1); PG8_STAGE(PG8_SA(0, 0), a2, voffA);
            PG8_BAR; PG8_WAIT_L(0); PG8_MMA(1, 0, At, B0); PG8_BAR; PG8_SCHED;
            PG8_STAGE(PG8_SB(0, 1), b2 + hstep, voffB);
            PG8_WAIT_V(6); PG8_BAR; PG8_MMA(1, 1, At, B1); PG8_BAR;
            PG8_LDB(B0, 1, 0); PG8_SCHED; PG8_LDA(At, 1, 0); PG8_STAGE(PG8_SA(0, 1), a2 + hstep, voffA);
            PG8_WAIT_L(8); PG8_BAR; PG8_WAIT_L(0); PG8_MMA(0, 0, At, B0); PG8_BAR; PG8_SCHED;
            PG8_LDB(B1, 1, 1); PG8_STAGE(PG8_SB(1, 0), b3, voffB);
            PG8_BAR; PG8_WAIT_L(0); PG8_MMA(0, 1, At, B1); PG8_BAR;
            PG8_LDA(At, 1, 1); PG8_STAGE(PG8_SA(1, 0), a3, voffA);
            PG8_BAR; PG8_WAIT_L(0); PG8_MMA(1, 0, At, B0); PG8_BAR; PG8_SCHED;
            PG8_STAGE(PG8_SB(1, 1), b3 + hstep, voffB);
            PG8_WAIT_V(6); PG8_BAR; PG8_MMA(1, 1, At, B1); PG8_BAR;
            }
        }
        if constexpr (ALIGN_EPI) { if (wr == 0) PG8_BAR; }
        if constexpr (!Epi::AFTER_DRAIN) { E(acc, cur, wr, wc, fr, fq); S.done(cur); }
        if (!has_next) break;
#pragma unroll
        for (int a = 0; a < 2; ++a)
#pragma unroll
            for (int b = 0; b < 2; ++b)
#pragma unroll
                for (int m = 0; m < 4; ++m)
#pragma unroll
                    for (int n = 0; n < 2; ++n) acc[a][b][m][n] = (f32x4){0.f, 0.f, 0.f, 0.f};
        cur = nxt; cA = nA; cB = nB; ++ui;
        if constexpr (ALIGN_EPI) { if (wr == 1) PG8_BAR; }
    }
    PG8_WAIT_V(0);
    if constexpr (!ALIGN_EPI) { if (wr == 0) PG8_BAR; }
    PG8_BAR;
    if constexpr (Epi::AFTER_DRAIN) { E.fused(acc, cur, wr, wc, fr, fq, lds, wid, lane); S.done(cur); }
#undef PG8_SA
#undef PG8_SB
#undef PG8_STAGE
#undef PG8_LDA
#undef PG8_LDB
#undef PG8_MMA
#undef PG8_WAIT_V
#undef PG8_WAIT_L
#undef PG8_BAR
#undef PG8_SCHED
}
}
#define GAS __attribute__((address_space(1)))
#define LAS __attribute__((address_space(3)))
typedef unsigned short bf16;
typedef unsigned v4u __attribute__((ext_vector_type(4)));
typedef float f32x4 __attribute__((ext_vector_type(4)));
typedef short bf16x8 __attribute__((ext_vector_type(8)));
typedef GAS unsigned gu32;
typedef GAS unsigned long long gu64;
#define RLX_AGENT __ATOMIC_RELAXED, __HIP_MEMORY_SCOPE_AGENT
#define LDS_WAIT() asm volatile("s_waitcnt lgkmcnt(0)" ::: "memory")
#define VM_WAIT() asm volatile("s_waitcnt vmcnt(0)" ::: "memory")
__device__ __forceinline__ unsigned long long rt() { return __builtin_amdgcn_s_memrealtime(); }
__device__ __forceinline__ unsigned f2bf(float f) { unsigned u = __builtin_bit_cast(unsigned, f); return (u + 0x7fffu + ((u >> 16) & 1u)) >> 16; }
__device__ __forceinline__ unsigned pk2(float lo, float hi) { return f2bf(lo) | (f2bf(hi) << 16); }

#define XB_TMO      128
#define XB_XCNT(j)  (256  + 64 * (j))
#define XB_XSUB(j)  (1280 + 64 * (j))
#define XB_XGEN(j)  (2304 + 64 * (j))
#define XB_TOP      3328
#define XB_TOPGEN   3392
#define XCD_BAR_WORDS 3456
#define XB_SPIN_CAP (1u << 18)

__device__ __forceinline__ unsigned xb_ld(unsigned* p)              { return __hip_atomic_load(p, __ATOMIC_RELAXED, __HIP_MEMORY_SCOPE_AGENT); }
__device__ __forceinline__ unsigned xb_add(unsigned* p, unsigned v) { return __hip_atomic_fetch_add(p, v, __ATOMIC_RELAXED, __HIP_MEMORY_SCOPE_AGENT); }
__device__ __forceinline__ unsigned xb_xcc_id() { return (unsigned)__builtin_amdgcn_s_getreg((3 << 11) | 20) & 0xFu; }
#define XB_SPIN(cond, bar) do { unsigned _sp = 0; while (cond) { __builtin_amdgcn_s_sleep(1); \
    if ((++_sp & 255u) == 0u) { if (xb_ld(&(bar)[XB_TMO])) break; if (_sp > XB_SPIN_CAP) { atomicAdd(&(bar)[XB_TMO], 1u); break; } } } } while (0)

struct XcdBarrier {
    unsigned* bar; unsigned x;
    volatile LAS unsigned* st;
};

__device__ __forceinline__ XcdBarrier xcd_barrier_post(unsigned* bar, volatile LAS unsigned* st) {
    XcdBarrier b; b.bar = bar; b.x = xb_xcc_id(); b.st = st;
    if (threadIdx.x == 0) (void)xb_add(&bar[XB_XCNT(b.x)], 1u);
    return b;
}
__device__ __forceinline__ void xcd_barrier_complete(unsigned* bar, unsigned x, unsigned& nloc, unsigned& nx) {
    const unsigned G = gridDim.x * gridDim.y * gridDim.z;
    unsigned sum, cnt, mine, sp = 0u;
    for (;;) {
        sum = 0u; cnt = 0u; mine = 0u;
#pragma unroll
        for (unsigned j = 0; j < 16; ++j) { const unsigned c = xb_ld(&bar[XB_XCNT(j)]); sum += c; cnt += (c > 0u) ? 1u : 0u; mine = (j == x) ? c : mine; }
        if (sum == G) break;
        __builtin_amdgcn_s_sleep(1);
        if ((++sp & 255u) == 0u) { if (xb_ld(&bar[XB_TMO])) break; if (sp > XB_SPIN_CAP) { atomicAdd(&bar[XB_TMO], 1u); break; } }
    }
    nloc = mine > 0u ? mine : 1u; nx = cnt > 0u ? cnt : 1u;
}

__device__ __forceinline__ void xcd_barrier(const XcdBarrier& b, const bool leader_thread) {
    asm volatile("s_waitcnt vmcnt(0)" ::: "memory");
    __syncthreads();
    if (leader_thread) {
        unsigned* bar = b.bar;
        __builtin_amdgcn_s_waitcnt(0);
        unsigned nloc = b.st[0], nx = b.st[1];
        if (nloc == 0u) { xcd_barrier_complete(bar, b.x, nloc, nx); b.st[0] = nloc; b.st[1] = nx; }
        const unsigned old = xb_add(&bar[XB_XSUB(b.x)], 1u);
        const unsigned gen = old / nloc;
        if (old + 1u == (gen + 1u) * nloc) {
            __builtin_amdgcn_fence(__ATOMIC_RELEASE, "agent");
            asm volatile("s_waitcnt vmcnt(0)" ::: "memory");
            const unsigned og = xb_add(&bar[XB_TOP], 1u);
            const unsigned tg = og / nx;
            if (og + 1u == (tg + 1u) * nx) xb_add(&bar[XB_TOPGEN], 1u);
            else XB_SPIN(xb_ld(&bar[XB_TOPGEN]) == tg, bar);
            __builtin_amdgcn_fence(__ATOMIC_ACQUIRE, "agent");
            xb_add(&bar[XB_XGEN(b.x)], 1u);
            asm volatile("s_waitcnt vmcnt(0)" ::: "memory");
        } else {
            XB_SPIN(xb_ld(&bar[XB_XGEN(b.x)]) == gen, bar);
            __builtin_amdgcn_fence(__ATOMIC_ACQUIRE, "agent");
            asm volatile("s_waitcnt vmcnt(0)" ::: "memory");
        }
    }
    __syncthreads();
}

typedef short s16x4 __attribute__((ext_vector_type(4)));
typedef float f32x16 __attribute__((ext_vector_type(16)));
typedef float f32x2_t __attribute__((ext_vector_type(2)));
typedef __bf16 bf16x2_t __attribute__((ext_vector_type(2)));
typedef unsigned u32x2 __attribute__((ext_vector_type(2)));
#define CAS __attribute__((address_space(4)))
#define DI __device__ __forceinline__
DI unsigned cvtpk(float lo, float hi) { f32x2_t v = {lo, hi}; bf16x2_t b = __builtin_convertvector(v, bf16x2_t); return __builtin_bit_cast(unsigned, b); }
DI float bf2f(unsigned short b) { return __uint_as_float((unsigned)b << 16); }
DI float wave_sum(float v) {
#pragma unroll
    for (int o = 1; o < 64; o <<= 1) v += __shfl_xor(v, o);
    return v;
}
struct Args { const float* in[19]; float* out; unsigned char* ws; int ph_lo, ph_hi, li, pad; };
enum { I_XP = 0, I_XS, I_CK, I_CV, I_SC, I_SG, I_LN0G, I_LN0B, I_WIN, I_RB, I_CW, I_ALOG, I_DTB, I_GNW, I_WA, I_WB, I_WO, I_LNG, I_LNB };
struct Frame {
    LAS unsigned char* lds; volatile LAS unsigned* MISC; gu32* ctl;
    int tid, lane, wave, vcu, G, bx;
};

DI int win_dst_row(int n) { return n < 4096 ? n : (n < 4112 ? 6144 + (n - 4096) : 4096 + (n - 4112)); }
template <bool WINMAP> DI void tr_item(const float* W, int N, bf16* WT, int ldk, int koff, int kb, int nb, LAS float* scr, int lane) {
    const int k0 = 64 * kb, n0 = 32 * nb;
#pragma unroll 8
    for (int i = 0; i < 32; ++i) { const int kk = 2 * i + (lane >> 5), n = n0 + (lane & 31); scr[kk * 33 + (lane & 31)] = (n < N) ? W[(size_t)(k0 + kk) * N + n] : 0.f; }
    LDS_WAIT(); asm volatile("" ::: "memory");
    const int c = lane & 7;
#pragma unroll
    for (int j = 0; j < 4; ++j) { const int nn = (lane >> 3) + 8 * j, n = n0 + nn; const LAS float* s = scr + (8 * c) * 33 + nn;
        v4u o; o.x = pk2(s[0 * 33], s[1 * 33]); o.y = pk2(s[2 * 33], s[3 * 33]); o.z = pk2(s[4 * 33], s[5 * 33]); o.w = pk2(s[6 * 33], s[7 * 33]);
        if (n < N) { const int dr = WINMAP ? win_dst_row(n) : n; *(GAS v4u*)(WT + (size_t)dr * ldk + koff + k0 + 8 * c) = o; } }
    LDS_WAIT(); asm volatile("" ::: "memory");
}
DI void ln_row(const float* src, const float* g, const float* b, float* hout, bf16* hbout, int lane) {
    const GAS f32x4* xr = (const GAS f32x4*)src + lane;
    f32x4 v[4]; float s = 0.f;
#pragma unroll
    for (int j = 0; j < 4; ++j) { v[j] = xr[64 * j]; s += (v[j].x + v[j].y) + (v[j].z + v[j].w); }
    const float mean = wave_sum(s) * (1.f / D); float s2 = 0.f;
#pragma unroll
    for (int j = 0; j < 4; ++j) { v[j] = v[j] - mean; s2 += (v[j].x * v[j].x + v[j].y * v[j].y) + (v[j].z * v[j].z + v[j].w * v[j].w); }
    const float rstd = 1.f / sqrtf(wave_sum(s2) * (1.f / D) + LN_EPS);
    GAS f32x4* ho = (GAS f32x4*)hout + lane; GAS unsigned long long* o8 = (GAS unsigned long long*)hbout + lane;
#pragma unroll
    for (int j = 0; j < 4; ++j) { const f32x4 gg = ((const GAS f32x4*)g)[lane + 64 * j], bb = ((const GAS f32x4*)b)[lane + 64 * j];
        const f32x4 y = v[j] * rstd * gg + bb; ho[64 * j] = y;
        o8[64 * j] = (unsigned long long)pk2(y.x, y.y) | ((unsigned long long)pk2(y.z, y.w) << 32); }
}
DI void p0_prologue(Frame& F, const CAS Args& A) {
    unsigned char* ws = A.ws;
    LAS float* scr = (LAS float*)(F.lds + RING_OFF + F.wave * 16384);
    const int gw = F.vcu * NWAVES + F.wave, NGW = F.G * NWAVES;
    constexpr int NB_IN = (IN_DIM + 31) / 32;
    constexpr int IT_IN = 16 * NB_IN, IT_A = 8 * 32, IT_O = 16 * 32, IT_L = IT_IN + 2 * IT_A + IT_O;
    for (int it = gw; it < DEPTH * IT_L; it += NGW) {
        const int l = it / IT_L; int r = it % IT_L;
        bf16* WinT = (bf16*)(ws + WS_WIN) + (size_t)l * NIN * D; bf16* WabT = (bf16*)(ws + WS_WAB) + (size_t)l * D * 1024; bf16* WoT = (bf16*)(ws + WS_WO) + (size_t)l * D * D;
        if (r < IT_IN) { tr_item<true>(A.in[I_WIN] + (size_t)l * D * IN_DIM, IN_DIM, WinT, D, 0, r / NB_IN, r % NB_IN, scr, F.lane); continue; } r -= IT_IN;
        if (r < IT_A) { tr_item<false>(A.in[I_WA] + (size_t)l * AW * D, D, WabT, 1024, 0, r / 32, r % 32, scr, F.lane); continue; } r -= IT_A;
        if (r < IT_A) { tr_item<false>(A.in[I_WB] + (size_t)l * BW * D, D, WabT, 1024, 512, r / 32, r % 32, scr, F.lane); continue; } r -= IT_A;
        tr_item<false>(A.in[I_WO] + (size_t)l * D * D, D, WoT, D, 0, r / 32, r % 32, scr, F.lane);
    }
    { const int gt = F.vcu * (NWAVES * 64) + F.tid, NGT = F.G * NWAVES * 64; constexpr int PER_L = (NIN - IN_DIM) * D * 2 / 16;
      for (int i = gt; i < DEPTH * PER_L; i += NGT) { const int l = i / PER_L, r = i % PER_L;
          *(GAS v4u*)((unsigned char*)ws + WS_WIN + ((size_t)l * NIN + IN_DIM) * D * 2 + (size_t)r * 16) = (v4u){0u, 0u, 0u, 0u}; } }
    float* H = A.out + O_Y; bf16* HB = (bf16*)(ws + WS_HB);
    for (int m = gw; m < M; m += NGW) {
        const float* src = (m < MP) ? A.in[I_XP] + (size_t)m * D : A.in[I_XS] + (size_t)(m - MP) * D;
        ln_row(src, A.in[I_LN0G], A.in[I_LN0B], H + (size_t)m * D, HB + (size_t)m * D, F.lane);
    }
}

namespace att {
DI int crow(int r, int hi) { return (r & 3) + 8 * (r >> 2) + 4 * hi; }
typedef short v4i16_t __attribute__((ext_vector_type(4)));
DI s16x4 vtr(const LAS unsigned char* p) { return __builtin_bit_cast(s16x4, __builtin_amdgcn_ds_read_tr16_b64_v4i16((LAS v4i16_t*)p)); }
DI bf16x8 ldfrag(const bf16* p) { return *(const GAS bf16x8*)p; }
DI bf16x8 ldfrag(const float* p) { const f32x4 a = *(const GAS f32x4*)p, b = *(const GAS f32x4*)(p + 4); v4u w; w.x = cvtpk(a[0], a[1]); w.y = cvtpk(a[2], a[3]); w.z = cvtpk(b[0], b[1]); w.w = cvtpk(b[2], b[3]); return __builtin_bit_cast(bf16x8, w); }
struct State { f32x16 o0, o1; float m, l; };
DI bf16x8 packp(const f32x16& p, int s) { v4u w; w.x = cvtpk(p[8 * s], p[8 * s + 1]); w.y = cvtpk(p[8 * s + 2], p[8 * s + 3]); w.z = cvtpk(p[8 * s + 4], p[8 * s + 5]); w.w = cvtpk(p[8 * s + 6], p[8 * s + 7]); return __builtin_bit_cast(bf16x8, w); }
template <typename T> DI void tile(State& st, const bf16x8 (&qr)[4], const T* kb, const T* vb, int pitch, int nvalid, int dq, const LAS float* btab, LAS unsigned char* vl, int lane) {
    const int r32 = lane & 31, hq = lane >> 5;
    bf16x8 kf[2][4];
#pragma unroll
    for (int sub = 0; sub < 2; ++sub) { int row = sub * 32 + r32; row = row < nvalid ? row : nvalid - 1;
#pragma unroll
        for (int ks = 0; ks < 4; ++ks) kf[sub][ks] = ldfrag(kb + (size_t)row * pitch + ks * 16 + hq * 8); }
    bf16x8 vreg[8];
#pragma unroll
    for (int i = 0; i < 8; ++i) { int row = i * 8 + (lane >> 3); row = row < nvalid ? row : nvalid - 1; vreg[i] = ldfrag(vb + (size_t)row * pitch + (lane & 7) * 8); }
    asm volatile("" ::: "memory");
#pragma unroll
    for (int i = 0; i < 8; ++i) { const int row = i * 8 + (lane >> 3); *(LAS bf16x8*)(vl + row * 128 + (((lane & 7) * 16) ^ (((row >> 1) & 1) << 6))) = vreg[i]; }
    f32x16 p0, p1;
#pragma unroll
    for (int r = 0; r < 16; ++r) { p0[r] = 0.f; p1[r] = 0.f; }
#pragma unroll
    for (int ks = 0; ks < 4; ++ks) { p0 = __builtin_amdgcn_mfma_f32_32x32x16_bf16(kf[0][ks], qr[ks], p0, 0, 0, 0); p1 = __builtin_amdgcn_mfma_f32_32x32x16_bf16(kf[1][ks], qr[ks], p1, 0, 0, 0); }
    if (dq >= 191) { const float bc = btab[191];
#pragma unroll
        for (int r = 0; r < 16; ++r) { p0[r] += bc; p1[r] += bc; }
    } else {
#pragma unroll
        for (int r = 0; r < 16; ++r) { int i0 = dq + r32 - crow(r, hq) + 63; int i1 = i0 - 32;
            i0 = i0 < 0 ? 0 : (i0 > 191 ? 191 : i0); i1 = i1 < 0 ? 0 : (i1 > 191 ? 191 : i1); p0[r] += btab[i0]; p1[r] += btab[i1]; }
    }
    if (nvalid < 64) {
#pragma unroll
        for (int r = 0; r < 16; ++r) { if (crow(r, hq) >= nvalid) p0[r] = -INFINITY; if (crow(r, hq) + 32 >= nvalid) p1[r] = -INFINITY; }
    }
    float mx = p0[0];
#pragma unroll
    for (int r = 1; r < 16; ++r) mx = fmaxf(mx, p0[r]);
#pragma unroll
    for (int r = 0; r < 16; ++r) mx = fmaxf(mx, p1[r]);
    mx = fmaxf(mx, __shfl_xor(mx, 32));
    const float mnew = fmaxf(st.m, mx), alpha = __builtin_amdgcn_exp2f(st.m - mnew); st.m = mnew;
    float sum = 0.f;
#pragma unroll
    for (int r = 0; r < 16; ++r) { p0[r] = __builtin_amdgcn_exp2f(p0[r] - mnew); p1[r] = __builtin_amdgcn_exp2f(p1[r] - mnew); sum += p0[r] + p1[r]; }
    st.l = st.l * alpha + sum;
#pragma unroll
    for (int r = 0; r < 16; ++r) { st.o0[r] *= alpha; st.o1[r] *= alpha; }
    bf16x8 pb[4]; pb[0] = packp(p0, 0); pb[1] = packp(p0, 1); pb[2] = packp(p1, 0); pb[3] = packp(p1, 1);
    asm volatile("" ::: "memory");
    const int blk = (lane >> 4) & 1, qq = (lane & 15) >> 2, pp = lane & 3, swz = ((qq >> 1) & 1) << 6;
#pragma unroll
    for (int s4 = 0; s4 < 4; ++s4) {
        const int rb = 16 * s4 + 4 * hq + qq;
#pragma unroll
        for (int d0 = 0; d0 < 2; ++d0) {
            const int cb = (d0 * 64 + blk * 32 + pp * 8) ^ swz;
            const s16x4 lo = vtr(vl + rb * 128 + cb), hi = vtr(vl + (rb + 8) * 128 + cb);
            const bf16x8 a = __builtin_shufflevector(lo, hi, 0, 1, 2, 3, 4, 5, 6, 7);
            if (d0 == 0) st.o0 = __builtin_amdgcn_mfma_f32_32x32x16_bf16(a, pb[s4], st.o0, 0, 0, 0);
            else st.o1 = __builtin_amdgcn_mfma_f32_32x32x16_bf16(a, pb[s4], st.o1, 0, 0, 0);
        }
    }
    asm volatile("" ::: "memory");
}
DI void finish(State& st, bf16* Orow0, const bf16* Zrow0, int lane) {
    const int r32 = lane & 31, hq = lane >> 5;
    const float lt = st.l + __shfl_xor(st.l, 32), inv = 1.0f / lt;
#pragma unroll
    for (int d0 = 0; d0 < 2; ++d0)
#pragma unroll
        for (int g = 0; g < 4; ++g) { const int d = 32 * d0 + 8 * g + 4 * hq;
            const u32x2 z = *(const GAS u32x2*)(Zrow0 + (size_t)r32 * 512 + d);
            const f32x16& o = d0 ? st.o1 : st.o0;
            const float a0 = o[4 * g] * inv * __uint_as_float(z.x << 16), a1 = o[4 * g + 1] * inv * __uint_as_float(z.x & 0xffff0000u);
            const float a2 = o[4 * g + 2] * inv * __uint_as_float(z.y << 16), a3 = o[4 * g + 3] * inv * __uint_as_float(z.y & 0xffff0000u);
            u32x2 w; w.x = cvtpk(a0, a1); w.y = cvtpk(a2, a3);
            *(GAS u32x2*)(Orow0 + (size_t)r32 * 1024 + d) = w; }
}
}

DI void p_attention(Frame& F, const CAS Args& A, int l, bool dummy = false) {
    unsigned char* ws = A.ws;
    bf16* OAB = (bf16*)(ws + WS_OAB); bf16* ODST = dummy ? (bf16*)(ws + WS_HB) : OAB;   const bf16* KA = (const bf16*)(ws + WS_KA); const bf16* VA = (const bf16*)(ws + WS_VA); const bf16* SZA = (const bf16*)(ws + WS_SZA);
    LAS float* btab_all = (LAS float*)(F.lds + BIAS_OFF);
    for (int i = F.tid; i < AH * NREL; i += NWAVES * 64) btab_all[i] = A.in[I_RB][(size_t)l * AH * NREL + i] * LOG2E;
    __syncthreads();
    LAS unsigned char* vl = F.lds + RING_OFF + F.wave * 16384;
    const int lane = F.lane, r32 = lane & 31, hq = lane >> 5;
    constexpr int NU_P = BATCH * (SEQ / CHUNK) * 2, NU = NU_P + DECB;
    for (int u = F.vcu; u < NU; u += F.G) {
        att::State st;
#pragma unroll
        for (int r = 0; r < 16; ++r) { st.o0[r] = 0.f; st.o1[r] = 0.f; }
        st.m = -1e30f; st.l = 0.f;
        bf16x8 qr[4];
        if (u < NU_P) {
            const int b = u >> 8, c = (u & 255) >> 1, h = (u & 1) * 4 + (F.wave >> 1), hf = F.wave & 1;
            const size_t qrow0 = (size_t)b * SEQ + c * CHUNK + hf * 32;
            bf16* Qp = OAB + qrow0 * 1024 + h * 64;
#pragma unroll
            for (int ks = 0; ks < 4; ++ks) qr[ks] = att::ldfrag(Qp + (size_t)r32 * 1024 + ks * 16 + hq * 8);
            const LAS float* btab = btab_all + h * NREL;
            for (int j = (c >= 8 ? c - 8 : 0); j <= c; ++j) {
                const size_t kr0 = ((size_t)b * SEQ + j * CHUNK) * 512 + h * 64;
                att::tile<bf16>(st, qr, KA + kr0, VA + kr0, 512, 64, (c - j) * 64 + hf * 32, btab, vl, lane);
            }
            att::finish(st, ODST + qrow0 * 1024 + h * 64, SZA + qrow0 * 512 + h * 64, lane);
        } else {
            const int b = u - NU_P, h = F.wave;
            const size_t qrow0 = (size_t)MP + b * DECS;
            bf16* Qp = OAB + qrow0 * 1024 + h * 64;
#pragma unroll
            for (int ks = 0; ks < 4; ++ks) qr[ks] = att::ldfrag(Qp + (size_t)r32 * 1024 + ks * 16 + hq * 8);
            const LAS float* btab = btab_all + h * NREL;
            const float* ck = A.in[I_CK] + ((size_t)(l * DECB + b) * ATTW) * 512 + h * 64;
            const float* cv = A.in[I_CV] + ((size_t)(l * DECB + b) * ATTW) * 512 + h * 64;
            for (int j = 0; j < 8; ++j) att::tile<float>(st, qr, ck + (size_t)j * 64 * 512, cv + (size_t)j * 64 * 512, 512, 64, 512 - 64 * j, btab, vl, lane);
            att::tile<bf16>(st, qr, KA + qrow0 * 512 + h * 64, VA + qrow0 * 512 + h * 64, 512, 32, 0, btab, vl, lane);
            att::finish(st, ODST + qrow0 * 1024 + h * 64, SZA + qrow0 * 512 + h * 64, lane);
        }
    }
}

DI void p_gdn_slow(Frame& F, const CAS Args& A, int l) {
    unsigned char* ws = A.ws;
    bf16* OAB = (bf16*)(ws + WS_OAB); const bf16* XB = (const bf16*)(ws + WS_XB); const float* G = (const float*)(ws + WS_G); const float* BETA = (const float*)(ws + WS_BETA);
    int sid = -1;
    if (F.vcu < 32) { if (F.wave == 0) sid = F.vcu; } else if (F.vcu < 64) sid = 32 + (F.vcu - 32) * 8 + F.wave;
    if (sid < 0) return;
    const bool prompt = sid < 32; const int sq = prompt ? sid : sid - 32; const int b = sq >> 3, h = sq & 7, T = prompt ? SEQ : DECS;
    const size_t rowbase = prompt ? (size_t)b * SEQ : (size_t)MP + b * DECS;
    const int e = F.lane, cq = h * 64 + e, ck = 512 + cq, cv = 1024 + cq;
    const float* cw = A.in[I_CW] + (size_t)l * 4 * BQKV;
    LAS float* wl = (LAS float*)(F.lds + RING_OFF + F.wave * 16384) + 128;
#pragma unroll
    for (int i = 0; i < 4; ++i) { wl[i * 64 + e] = cw[i * BQKV + cq]; wl[(4 + i) * 64 + e] = cw[i * BQKV + ck]; wl[(8 + i) * 64 + e] = cw[i * BQKV + cv]; }
    float xq[3] = {0.f, 0.f, 0.f}, xk[3] = {0.f, 0.f, 0.f}, xv[3] = {0.f, 0.f, 0.f};
    float S[64];
#pragma unroll
    for (int d = 0; d < 64; ++d) S[d] = 0.f;
    if (!prompt) {
        const float* sc = A.in[I_SC] + ((size_t)(l * DECB + b) * 3) * BQKV;
#pragma unroll
        for (int i = 0; i < 3; ++i) { xq[i] = sc[i * BQKV + cq]; xk[i] = sc[i * BQKV + ck]; xv[i] = sc[i * BQKV + cv]; }
        const float* s0 = A.in[I_SG] + ((size_t)(l * DECB + b) * BH + h) * 4096;
#pragma unroll
        for (int d = 0; d < 64; ++d) S[d] = s0[d * 64 + e];
    }
    const float nw = A.in[I_GNW][l * 64 + e];
    const float nAexp = -expf(A.in[I_ALOG][l * 8 + h]), dtb = A.in[I_DTB][l * 8 + h];
    LAS float* kbuf = (LAS float*)(F.lds + RING_OFF + F.wave * 16384); LAS float* qbuf = kbuf + 64;
    for (int t = 0; t < T; ++t) {
        const size_t row = rowbase + t;
        const float nq = bf2f(XB[row * BQKV + cq]), nk = bf2f(XB[row * BQKV + ck]), nv = bf2f(XB[row * BQKV + cv]);
        const float aq = xq[0] * wl[e] + xq[1] * wl[64 + e] + xq[2] * wl[128 + e] + nq * wl[192 + e];
        const float ak = xk[0] * wl[256 + e] + xk[1] * wl[320 + e] + xk[2] * wl[384 + e] + nk * wl[448 + e];
        const float av = xv[0] * wl[512 + e] + xv[1] * wl[576 + e] + xv[2] * wl[640 + e] + nv * wl[704 + e];
        xq[0] = xq[1]; xq[1] = xq[2]; xq[2] = nq; xk[0] = xk[1]; xk[1] = xk[2]; xk[2] = nk; xv[0] = xv[1]; xv[1] = xv[2]; xv[2] = nv;
        const float q = aq / (1.f + expf(-aq)), k = ak / (1.f + expf(-ak)), v = av / (1.f + expf(-av));
        const float sqq = wave_sum(q * q), skk = wave_sum(k * k);
        const float qn = q * (1.0f / sqrtf(sqq + NORM_EPS)) * 0.125f, kn = k * (1.0f / sqrtf(skk + NORM_EPS));
        const float xa = G[row * 8 + h] + dtb, sp = xa > 20.f ? xa : log1pf(expf(xa));
        const float g = nAexp * sp, beta = 1.0f / (1.0f + expf(-BETA[row * 8 + h])), a = expf(g);
        asm volatile("" ::: "memory");
        kbuf[e] = kn; qbuf[e] = qn;
        asm volatile("s_waitcnt lgkmcnt(0)" ::: "memory");
        float kS = 0.f;
#pragma unroll
        for (int d = 0; d < 64; ++d) kS += kbuf[d] * S[d];
        const float coef = beta * (v - a * kS);
        float o = 0.f;
#pragma unroll
        for (int d = 0; d < 64; ++d) { S[d] = a * S[d] + kbuf[d] * coef; o += qbuf[d] * S[d]; }
        asm volatile("s_waitcnt lgkmcnt(0)" ::: "memory");
        const float ms = wave_sum(o * o) * (1.f / 64.f);
        const float on = o * (1.0f / sqrtf(ms + NORM_EPS)) * nw;
        bf16* op = OAB + row * 1024 + 512 + cq;
        *op = (bf16)f2bf(on * bf2f(*op));
    }
    float* so = A.out + (prompt ? O_GP + ((size_t)(l * BATCH + b) * BH + h) * 4096 : O_GS + ((size_t)(l * DECB + b) * BH + h) * 4096);
#pragma unroll
    for (int d = 0; d < 64; ++d) so[d * 64 + e] = S[d];
}


namespace gdn {
DI int crow(int r, int h) { return (r & 3) + 8 * (r >> 2) + 4 * h; }
DI int pfun4(int dk) { return (dk & 32) | (((dk >> 2) & 3) << 3) | (((dk >> 4) & 1) << 2); }
typedef short v4i16_t __attribute__((ext_vector_type(4)));
DI s16x4 vtr(const LAS unsigned char* p) { return __builtin_bit_cast(s16x4, __builtin_amdgcn_ds_read_tr16_b64_v4i16((LAS v4i16_t*)p)); }
DI bf16x8 packacc(const f32x16& p, int s) { v4u w; w.x = cvtpk(p[8 * s], p[8 * s + 1]); w.y = cvtpk(p[8 * s + 2], p[8 * s + 3]); w.z = cvtpk(p[8 * s + 4], p[8 * s + 5]); w.w = cvtpk(p[8 * s + 6], p[8 * s + 7]); return __builtin_bit_cast(bf16x8, w); }
DI f32x16 zero16() { f32x16 z;
#pragma unroll
    for (int i = 0; i < 16; ++i) z[i] = 0.f;
    return z; }
#define MFMA32(a, b, c) __builtin_amdgcn_mfma_f32_32x32x16_bf16((a), (b), (c), 0, 0, 0)
DI bf16x8 trfrag(const LAS unsigned char* img, int rlo, int rhi, int ct, int lane) {
    const int blk = (lane >> 4) & 1, qq = (lane & 15) >> 2, pp = lane & 3, swz = ((qq >> 1) & 1) << 6;
    const int cb = (ct * 64 + blk * 32 + pp * 8) ^ swz;
    const s16x4 lo = vtr(img + (rlo + qq) * 128 + cb), hi = vtr(img + (rhi + qq) * 128 + cb);
    return __builtin_shufflevector(lo, hi, 0, 1, 2, 3, 4, 5, 6, 7);
}
template <int CMAX> DI void subst(float (&T)[64], const LAS float* MT, int myrow) {
#pragma unroll
    for (int c = CMAX; c >= 0; --c) {
        float acc = (myrow == c) ? 1.f : 0.f;
#pragma unroll
        for (int j4 = ((c + 1) & ~3); j4 <= CMAX; j4 += 4) {
            const f32x4 m = *(const LAS f32x4*)(MT + c * 68 + j4);
#pragma unroll
            for (int t = 0; t < 4; ++t) if (j4 + t > c) acc -= T[j4 + t] * m[t];
            if ((j4 & 12) == 12) asm volatile("" : "+v"(acc) :: "memory");
        }
        asm volatile("" : "+v"(acc) :: "memory");
        T[c] = acc;
    }
}
}

DI void p_conv(Frame& F, const CAS Args& A, int l) {
    unsigned char* ws = A.ws;
    bf16* XB = (bf16*)(ws + WS_XB); const bf16* HALO = (const bf16*)(ws + WS_HALO);
    const float* cw = A.in[I_CW] + (size_t)l * 4 * BQKV;
    const int gw = F.vcu * NWAVES + F.wave, NGW = F.G * NWAVES, lane = F.lane;
    constexpr int NU = (MP / 64) * 3 + DECB * 3;
    for (int u = gw; u < NU; u += NGW) {
        const bool prompt = u < (MP / 64) * 3;
        const int ci = prompt ? u / 3 : (u - (MP / 64) * 3) / 3, sec = prompt ? u % 3 : (u - (MP / 64) * 3) % 3;
        const size_t row0 = prompt ? (size_t)ci * 64 : (size_t)MP + ci * DECS; const int nrows = prompt ? 64 : DECS;
        const int col = sec * 512 + lane * 8;
        float w0[8], w1[8], w2[8], w3[8], x0[8], x1[8], x2[8];
#pragma unroll
        for (int j = 0; j < 8; ++j) { w0[j] = cw[col + j]; w1[j] = cw[BQKV + col + j]; w2[j] = cw[2 * BQKV + col + j]; w3[j] = cw[3 * BQKV + col + j]; x0[j] = 0.f; x1[j] = 0.f; x2[j] = 0.f; }
        if (prompt) {
            if ((ci & 127) != 0) {
                const bf16* hp = HALO + (size_t)(ci - 1) * 3 * BQKV + col;
                const v4u a = *(const GAS v4u*)hp, b = *(const GAS v4u*)(hp + BQKV), c = *(const GAS v4u*)(hp + 2 * BQKV);
#pragma unroll
                for (int j = 0; j < 4; ++j) { x0[2 * j] = __uint_as_float(a[j] << 16); x0[2 * j + 1] = __uint_as_float(a[j] & 0xffff0000u);
                    x1[2 * j] = __uint_as_float(b[j] << 16); x1[2 * j + 1] = __uint_as_float(b[j] & 0xffff0000u);
                    x2[2 * j] = __uint_as_float(c[j] << 16); x2[2 * j + 1] = __uint_as_float(c[j] & 0xffff0000u); }
            }
        } else {
            const float* sc = A.in[I_SC] + ((size_t)(l * DECB + ci) * 3) * BQKV + col;
#pragma unroll
            for (int j = 0; j < 8; ++j) { x0[j] = sc[j]; x1[j] = sc[BQKV + j]; x2[j] = sc[2 * BQKV + j]; }
        }
        bf16* rp = XB + row0 * BQKV + col;
        for (int t = 0; t < nrows; ++t, rp += BQKV) {
            const v4u raw = *(const GAS v4u*)rp; float xn[8], y[8]; float ss = 0.f;
#pragma unroll
            for (int j = 0; j < 4; ++j) { xn[2 * j] = __uint_as_float(raw[j] << 16); xn[2 * j + 1] = __uint_as_float(raw[j] & 0xffff0000u); }
#pragma unroll
            for (int j = 0; j < 8; ++j) { const float a = x0[j] * w0[j] + x1[j] * w1[j] + x2[j] * w2[j] + xn[j] * w3[j]; y[j] = a * __builtin_amdgcn_rcpf(1.0f + __expf(-a)); ss += y[j] * y[j];
                x0[j] = x1[j]; x1[j] = x2[j]; x2[j] = xn[j]; }
            if (sec < 2) {
                ss += __shfl_xor(ss, 1); ss += __shfl_xor(ss, 2); ss += __shfl_xor(ss, 4);
                const float sc = (1.0f / sqrtf(ss + NORM_EPS)) * (sec == 0 ? 0.125f : 1.0f);
#pragma unroll
                for (int j = 0; j < 8; ++j) y[j] *= sc;
            }
            v4u o; o.x = cvtpk(y[0], y[1]); o.y = cvtpk(y[2], y[3]); o.z = cvtpk(y[4], y[5]); o.w = cvtpk(y[6], y[7]);
            *(GAS v4u*)rp = o;
        }
    }
}

DI void gdn_prep_unit(const CAS Args& A, int l, LAS unsigned char* pw, int lane, int uid, size_t row0, int nvalid, int h) {
    using namespace gdn;
    unsigned char* ws = A.ws;
    const bf16* QKV = (const bf16*)(ws + WS_XB);
    const int r32 = lane & 31, hq = lane >> 5;
    LAS float* MT = (LAS float*)pw;
    LAS unsigned char* Kimg = pw; LAS unsigned char* Vimg = pw + 8192;
    LAS float* tb_gc = (LAS float*)(pw + 17408); LAS float* tb_beta = tb_gc + 64; LAS float* tb_bg = tb_gc + 128; LAS float* tb_dl = tb_gc + 192;
    const int qc = h * 64, kc = 512 + h * 64, vc = 1024 + h * 64;
    {
        const bool valid = lane < nvalid; const size_t row = row0 + (valid ? lane : 0);
        const float araw = ((const float*)(ws + WS_G))[row * 8 + h], braw = ((const float*)(ws + WS_BETA))[row * 8 + h];
        const float xa = araw + A.in[I_DTB][l * 8 + h], sp = xa > 20.f ? xa : log1pf(expf(xa));
        float g = valid ? -expf(A.in[I_ALOG][l * 8 + h]) * sp : 0.f; const float beta = valid ? 1.0f / (1.0f + expf(-braw)) : 0.f;
#pragma unroll
        for (int off = 1; off < 64; off <<= 1) { const float t2 = __shfl_up(g, off); if (lane >= off) g += t2; }
        const float glast = __shfl(g, 63);
        tb_gc[lane] = g; tb_beta[lane] = beta; tb_bg[lane] = beta * expf(g); tb_dl[lane] = expf(glast - g);
        if (lane == 0) ((float*)(ws + WS_GE))[uid] = expf(glast);
    }
    asm volatile("s_waitcnt lgkmcnt(0)" ::: "memory");
    bf16x8 kR[2][4], qR[2][4];
#pragma unroll
    for (int rt = 0; rt < 2; ++rt) { const int row = 32 * rt + r32; const bool ok = row < nvalid; const bf16* bp = QKV + (row0 + (ok ? row : 0)) * BQKV + 8 * hq;
#pragma unroll
        for (int ks = 0; ks < 4; ++ks) { bf16x8 kk = *(const GAS bf16x8*)(bp + kc + 16 * ks), qq = *(const GAS bf16x8*)(bp + qc + 16 * ks);
            if (!ok) { kk = (bf16x8){0, 0, 0, 0, 0, 0, 0, 0}; qq = kk; } kR[rt][ks] = kk; qR[rt][ks] = qq; } }
#pragma unroll
    for (int tix = 0; tix < 3; ++tix) { const int a = tix == 0 ? 0 : 1, b = tix == 2 ? 1 : 0;
        f32x16 Gt = zero16();
#pragma unroll
        for (int ks = 0; ks < 4; ++ks) Gt = MFMA32(kR[a][ks], kR[b][ks], Gt);
        const int c = 32 * b + r32; const float gcc = tb_gc[c];
#pragma unroll
        for (int g4 = 0; g4 < 4; ++g4) { const int j0 = 32 * a + 8 * g4 + 4 * hq;
            const f32x4 gj = *(const LAS f32x4*)(tb_gc + j0), bj = *(const LAS f32x4*)(tb_beta + j0); f32x4 mv;
#pragma unroll
            for (int t = 0; t < 4; ++t) mv[t] = (j0 + t > c) ? bj[t] * __expf(gj[t] - gcc) * Gt[4 * g4 + t] : 0.f;
            *(LAS f32x4*)(MT + c * 68 + j0) = mv; } }
    bf16x8 Xp[3][2];
#pragma unroll
    for (int tix = 0; tix < 3; ++tix) { const int jt = tix == 2 ? 1 : 0, it = tix == 0 ? 0 : 1;
        f32x16 Xt = zero16();
#pragma unroll
        for (int ks = 0; ks < 4; ++ks) Xt = MFMA32(kR[jt][ks], qR[it][ks], Xt);
        const int i_ = 32 * it + r32; const float gci = tb_gc[i_];
#pragma unroll
        for (int g4 = 0; g4 < 4; ++g4) { const int j0 = 32 * jt + 8 * g4 + 4 * hq; const f32x4 gj = *(const LAS f32x4*)(tb_gc + j0);
#pragma unroll
            for (int t = 0; t < 4; ++t) Xt[4 * g4 + t] = (i_ >= j0 + t) ? Xt[4 * g4 + t] * __expf(gci - gj[t]) : 0.f; }
        Xp[tix][0] = packacc(Xt, 0); Xp[tix][1] = packacc(Xt, 1); }
    asm volatile("s_waitcnt lgkmcnt(0)" ::: "memory");
#if defined(PREP_CUT) && PREP_CUT == 1
    *(GAS bf16x8*)(ws + WS_GAO + (size_t)uid * 8192 + lane * 16) = Xp[0][0] + Xp[1][0] + Xp[2][0] + Xp[0][1] + Xp[1][1] + Xp[2][1]; return;
#endif
    bf16x8 Tv0[2], Tw0[2], Tv1[4], Tw1[4];
    {
        float T[64];
#pragma unroll
        for (int c = 0; c < 64; ++c) T[c] = 0.f;
        subst<31>(T, MT, r32);
#pragma unroll
        for (int ks = 0; ks < 2; ++ks) { const f32x4 b0 = *(const LAS f32x4*)(tb_beta + 16 * ks + 8 * hq), b1 = *(const LAS f32x4*)(tb_beta + 16 * ks + 8 * hq + 4);
            const f32x4 g0 = *(const LAS f32x4*)(tb_bg + 16 * ks + 8 * hq), g1 = *(const LAS f32x4*)(tb_bg + 16 * ks + 8 * hq + 4);
            float tv[8], tw[8];
#pragma unroll
            for (int j = 0; j < 8; ++j) { const float tt = hq ? T[16 * ks + 8 + j] : T[16 * ks + j]; tv[j] = tt * (j < 4 ? b0[j & 3] : b1[j & 3]); tw[j] = tt * (j < 4 ? g0[j & 3] : g1[j & 3]); }
            v4u a, b; a.x = cvtpk(tv[0], tv[1]); a.y = cvtpk(tv[2], tv[3]); a.z = cvtpk(tv[4], tv[5]); a.w = cvtpk(tv[6], tv[7]);
            b.x = cvtpk(tw[0], tw[1]); b.y = cvtpk(tw[2], tw[3]); b.z = cvtpk(tw[4], tw[5]); b.w = cvtpk(tw[6], tw[7]);
            Tv0[ks] = __builtin_bit_cast(bf16x8, a); Tw0[ks] = __builtin_bit_cast(bf16x8, b); }
    }
    {
        float T[64];
        subst<63>(T, MT, 32 + r32);
#pragma unroll
        for (int ks = 0; ks < 4; ++ks) { const f32x4 b0 = *(const LAS f32x4*)(tb_beta + 16 * ks + 8 * hq), b1 = *(const LAS f32x4*)(tb_beta + 16 * ks + 8 * hq + 4);
            const f32x4 g0 = *(const LAS f32x4*)(tb_bg + 16 * ks + 8 * hq), g1 = *(const LAS f32x4*)(tb_bg + 16 * ks + 8 * hq + 4);
            float tv[8], tw[8];
#pragma unroll
            for (int j = 0; j < 8; ++j) { const float tt = hq ? T[16 * ks + 8 + j] : T[16 * ks + j]; tv[j] = tt * (j < 4 ? b0[j & 3] : b1[j & 3]); tw[j] = tt * (j < 4 ? g0[j & 3] : g1[j & 3]); }
            v4u a, b; a.x = cvtpk(tv[0], tv[1]); a.y = cvtpk(tv[2], tv[3]); a.z = cvtpk(tv[4], tv[5]); a.w = cvtpk(tv[6], tv[7]);
            b.x = cvtpk(tw[0], tw[1]); b.y = cvtpk(tw[2], tw[3]); b.z = cvtpk(tw[4], tw[5]); b.w = cvtpk(tw[6], tw[7]);
            Tv1[ks] = __builtin_bit_cast(bf16x8, a); Tw1[ks] = __builtin_bit_cast(bf16x8, b); }
    }
    asm volatile("s_waitcnt lgkmcnt(0)" ::: "memory");
#if defined(PREP_CUT) && PREP_CUT == 2
    *(GAS bf16x8*)(ws + WS_GAO + (size_t)uid * 8192 + lane * 16) = Xp[0][0] + Xp[1][0] + Xp[2][0] + Xp[0][1] + Xp[1][1] + Xp[2][1] + Tv0[0] + Tv0[1] + Tw0[0] + Tw0[1] + Tv1[0] + Tv1[1] + Tv1[2] + Tv1[3] + Tw1[0] + Tw1[1] + Tw1[2] + Tw1[3]; return;
#endif
#pragma unroll
    for (int i = 0; i < 8; ++i) { const int row = i * 8 + (lane >> 3); const bool ok = row < nvalid; const bf16* bp = QKV + (row0 + (ok ? row : 0)) * BQKV + (lane & 7) * 8;
        bf16x8 kk = *(const GAS bf16x8*)(bp + kc), vv = *(const GAS bf16x8*)(bp + vc);
        if (!ok) { kk = (bf16x8){0, 0, 0, 0, 0, 0, 0, 0}; vv = kk; }
        const int off = row * 128 + (((lane & 7) * 16) ^ (((row >> 1) & 1) << 6));
        *(LAS bf16x8*)(Kimg + off) = kk; *(LAS bf16x8*)(Vimg + off) = vv; }
    asm volatile("s_waitcnt lgkmcnt(0)" ::: "memory");
    unsigned char* gAo = ws + WS_GAO + (size_t)uid * 8192; unsigned char* gBs = ws + WS_GBS + (size_t)uid * 8192;
    unsigned char* gCo = ws + WS_GCO + (size_t)uid * 8192; unsigned char* gCs = ws + WS_GCS + (size_t)uid * 8192;
    {
        bf16x8 Ub[2][2][2], Ud[2][2][2];
#pragma unroll
        for (int rt = 0; rt < 2; ++rt)
#pragma unroll
            for (int ct = 0; ct < 2; ++ct) { f32x16 acc = zero16();
#pragma unroll
                for (int ks = 0; ks < 4; ++ks) if (rt == 1 || ks < 2) acc = MFMA32(rt ? Tv1[ks] : Tv0[ks], trfrag(Vimg, 16 * ks + 8 * hq, 16 * ks + 8 * hq + 4, ct, lane), acc);
                Ub[rt][ct][0] = packacc(acc, 0); Ub[rt][ct][1] = packacc(acc, 1);
#pragma unroll
                for (int g4 = 0; g4 < 4; ++g4) { const f32x4 dl = *(const LAS f32x4*)(tb_dl + 32 * rt + 8 * g4 + 4 * hq);
#pragma unroll
                    for (int t = 0; t < 4; ++t) acc[4 * g4 + t] *= dl[t]; }
                Ud[rt][ct][0] = packacc(acc, 0); Ud[rt][ct][1] = packacc(acc, 1); }
#pragma unroll
        for (int it = 0; it < 2; ++it)
#pragma unroll
            for (int ct = 0; ct < 2; ++ct) { f32x16 acc = zero16();
#pragma unroll
                for (int jt = 0; jt <= it; ++jt)
#pragma unroll
                    for (int s = 0; s < 2; ++s) acc = MFMA32(Xp[jt + it][s], Ub[jt][ct][s], acc);
#pragma unroll
                for (int g4 = 0; g4 < 4; ++g4) { u32x2 o; o.x = cvtpk(acc[4 * g4], acc[4 * g4 + 1]); o.y = cvtpk(acc[4 * g4 + 2], acc[4 * g4 + 3]);
                    *(GAS u32x2*)(gCo + ((32 * ct + r32) * 64 + 32 * it + 8 * g4 + 4 * hq) * 2) = o; } }
#pragma unroll
        for (int kt = 0; kt < 2; ++kt)
#pragma unroll
            for (int ct = 0; ct < 2; ++ct) { f32x16 acc = zero16();
#pragma unroll
                for (int lt = 0; lt < 2; ++lt)
#pragma unroll
                    for (int s = 0; s < 2; ++s) acc = MFMA32(trfrag(Kimg, 32 * lt + 16 * s + 4 * hq, 32 * lt + 16 * s + 8 + 4 * hq, kt, lane), Ud[lt][ct][s], acc);
#pragma unroll
                for (int g4 = 0; g4 < 4; ++g4) { u32x2 o; o.x = cvtpk(acc[4 * g4], acc[4 * g4 + 1]); o.y = cvtpk(acc[4 * g4 + 2], acc[4 * g4 + 3]);
                    *(GAS u32x2*)(gCs + ((32 * ct + r32) * 64 + 32 * kt + 8 * g4 + 4 * hq) * 2) = o; } }
    }
    {
        bf16x8 Wn[2][2][2], Wd[2][2][2];
#pragma unroll
        for (int rt = 0; rt < 2; ++rt)
#pragma unroll
            for (int kt = 0; kt < 2; ++kt) { f32x16 acc = zero16();
#pragma unroll
                for (int ks = 0; ks < 4; ++ks) if (rt == 1 || ks < 2) acc = MFMA32(rt ? Tw1[ks] : Tw0[ks], trfrag(Kimg, 16 * ks + 8 * hq, 16 * ks + 8 * hq + 4, kt, lane), acc);
                f32x16 neg;
#pragma unroll
                for (int i = 0; i < 16; ++i) neg[i] = -acc[i];
                Wn[rt][kt][0] = packacc(neg, 0); Wn[rt][kt][1] = packacc(neg, 1);
#pragma unroll
                for (int g4 = 0; g4 < 4; ++g4) { const f32x4 dl = *(const LAS f32x4*)(tb_dl + 32 * rt + 8 * g4 + 4 * hq);
#pragma unroll
                    for (int t = 0; t < 4; ++t) acc[4 * g4 + t] *= dl[t]; }
                Wd[rt][kt][0] = packacc(acc, 0); Wd[rt][kt][1] = packacc(acc, 1); }
#pragma unroll
        for (int kt = 0; kt < 2; ++kt)
#pragma unroll
            for (int it = 0; it < 2; ++it) { const int i_ = 32 * it + r32; const bool ok = i_ < nvalid; const float gam = ok ? __expf(tb_gc[i_]) : 0.f;
                const bf16* qp = QKV + (row0 + (ok ? i_ : 0)) * BQKV + qc + 32 * kt + 4 * hq; f32x16 acc;
#pragma unroll
                for (int g4 = 0; g4 < 4; ++g4) { const u32x2 qv = *(const GAS u32x2*)(qp + 8 * g4);
                    acc[4 * g4] = __uint_as_float(qv.x << 16) * gam; acc[4 * g4 + 1] = __uint_as_float(qv.x & 0xffff0000u) * gam;
                    acc[4 * g4 + 2] = __uint_as_float(qv.y << 16) * gam; acc[4 * g4 + 3] = __uint_as_float(qv.y & 0xffff0000u) * gam; }
#pragma unroll
                for (int jt = 0; jt <= it; ++jt)
#pragma unroll
                    for (int s = 0; s < 2; ++s) acc = MFMA32(Wn[jt][kt][s], Xp[jt + it][s], acc);
#pragma unroll
                for (int g4 = 0; g4 < 4; ++g4) { u32x2 o; o.x = cvtpk(acc[4 * g4], acc[4 * g4 + 1]); o.y = cvtpk(acc[4 * g4 + 2], acc[4 * g4 + 3]);
                    *(GAS u32x2*)(gAo + (i_ * 64 + pfun4(32 * kt + 8 * g4 + 4 * hq)) * 2) = o; } }
#pragma unroll
        for (int kt = 0; kt < 2; ++kt)
#pragma unroll
            for (int k2 = 0; k2 < 2; ++k2) { f32x16 acc = zero16();
#pragma unroll
                for (int lt = 0; lt < 2; ++lt)
#pragma unroll
                    for (int s = 0; s < 2; ++s) acc = MFMA32(Wd[lt][kt][s], trfrag(Kimg, 32 * lt + 16 * s + 4 * hq, 32 * lt + 16 * s + 8 + 4 * hq, k2, lane), acc);
#pragma unroll
                for (int g4 = 0; g4 < 4; ++g4) { u32x2 o; o.x = cvtpk(-acc[4 * g4], -acc[4 * g4 + 1]); o.y = cvtpk(-acc[4 * g4 + 2], -acc[4 * g4 + 3]);
                    *(GAS u32x2*)(gBs + ((32 * k2 + r32) * 64 + pfun4(32 * kt + 8 * g4 + 4 * hq)) * 2) = o; } }
    }
    asm volatile("s_waitcnt lgkmcnt(0)" ::: "memory");
}
DI void p_gdn_prep(Frame& F, const CAS Args& A, int l) {
    LAS unsigned char* pw = F.lds + F.wave * PW_BYTES;
    const int gw = F.vcu * NWAVES + F.wave, NGW = F.G * NWAVES;
    for (int u = gw; u < GD_UNITS; u += NGW) {
        int uid, h, nvalid; size_t row0;
        if (u < BATCH * BH * (SEQ / CHUNK)) { const int c = u >> 5, sq = u & 31, b = sq >> 3; h = sq & 7; uid = sq * (SEQ / CHUNK) + c; row0 = (size_t)b * SEQ + c * CHUNK; nvalid = 64; }
        else { const int sq = u - BATCH * BH * (SEQ / CHUNK), b = sq >> 3; h = sq & 7; uid = BATCH * BH * (SEQ / CHUNK) + sq; row0 = (size_t)MP + b * DECS; nvalid = DECS; }
        int lane_o = F.lane; asm volatile("" : "+v"(lane_o));
        gdn_prep_unit(A, l, pw, lane_o, uid, row0, nvalid, h);
    }
}

namespace gscan {
constexpr int ST_BYTES = 32768, NST = 3;
constexpr int OT_OFF = NST * ST_BYTES, OT_BYTES = 64 * 68 * 4;
constexpr int XB_OFF = OT_OFF + 2 * OT_BYTES;
constexpr int EV_OFF = XB_OFF + 2048;
static_assert(EV_OFF + 64 <= LDSCTL_OFF, "scan LDS map");
DI int swz(int row, int ch) { return row * 128 + ((ch ^ ((row >> 1) & 7)) << 4); }
}
DI void gdn_scan_seq(Frame& F, const CAS Args& A, int l, bool prompt, int sq) {
    using namespace gscan;
    unsigned char* ws = A.ws;
    const int b = sq >> 3, h = sq & 7, nch = prompt ? SEQ / CHUNK : 1, nrows = prompt ? 64 : DECS;
    const size_t rowbase = prompt ? (size_t)b * SEQ : (size_t)MP + b * DECS;
    const int uid0 = prompt ? sq * (SEQ / CHUNK) : BATCH * BH * (SEQ / CHUNK) + sq;
    const int lane = F.lane;
    LAS unsigned char* L0 = F.lds;
    if (F.wave < 4) {
        const int w4 = F.wave, r16 = lane & 15, q = lane >> 4;
        f32x4 S[4];
#pragma unroll
        for (int mt = 0; mt < 4; ++mt) S[mt] = (f32x4){0.f, 0.f, 0.f, 0.f};
        if (!prompt) { const float* s0 = A.in[I_SG] + ((size_t)(l * DECB + b) * BH + h) * 4096 + 16 * w4 + r16;
#pragma unroll
            for (int mt = 0; mt < 4; ++mt)
#pragma unroll
                for (int i = 0; i < 4; ++i) S[mt][i] = s0[(16 * mt + 4 * q + i) * 64]; }
        for (int t = -3; t <= nch; ++t) {
            if (t >= 0 && t < nch) {
                const LAS unsigned char* st = L0 + (t % NST) * ST_BYTES;
                const float e = ((const LAS float*)(L0 + EV_OFF))[t % NST];
                bf16x8 Sb[2];
#pragma unroll
                for (int s = 0; s < 2; ++s) { v4u w; w.x = cvtpk(S[2 * s][0], S[2 * s][1]); w.y = cvtpk(S[2 * s][2], S[2 * s][3]); w.z = cvtpk(S[2 * s + 1][0], S[2 * s + 1][1]); w.w = cvtpk(S[2 * s + 1][2], S[2 * s + 1][3]); Sb[s] = __builtin_bit_cast(bf16x8, w); }
                LAS float* ot = (LAS float*)(L0 + OT_OFF + (t & 1) * OT_BYTES); LAS float* xb = (LAS float*)(L0 + XB_OFF) + (t & 1) * 256 + w4 * 64;
                const int crow_ = 16 * w4 + r16;
#pragma unroll
                for (int mt = 0; mt < 4; ++mt) {
                    const int arow = 16 * mt + r16;
                    const bf16x8 b0 = *(const LAS bf16x8*)(st + swz(arow, q)), b1 = *(const LAS bf16x8*)(st + swz(arow, 4 + q));
                    const bf16x8 a0 = *(const LAS bf16x8*)(st + 8192 + swz(arow, q)), a1 = *(const LAS bf16x8*)(st + 8192 + swz(arow, 4 + q));
                    const u32x2 csr = *(const LAS u32x2*)(st + 16384 + swz(crow_, 2 * mt + (q >> 1)) + (q & 1) * 8), cor = *(const LAS u32x2*)(st + 24576 + swz(crow_, 2 * mt + (q >> 1)) + (q & 1) * 8);
                    f32x4 cs, co;
                    cs[0] = __uint_as_float(csr.x << 16); cs[1] = __uint_as_float(csr.x & 0xffff0000u); cs[2] = __uint_as_float(csr.y << 16); cs[3] = __uint_as_float(csr.y & 0xffff0000u);
                    co[0] = __uint_as_float(cor.x << 16); co[1] = __uint_as_float(cor.x & 0xffff0000u); co[2] = __uint_as_float(cor.y << 16); co[3] = __uint_as_float(cor.y & 0xffff0000u);
                    f32x4 as = S[mt] * e + cs;
                    as = __builtin_amdgcn_mfma_f32_16x16x32_bf16(b0, Sb[0], as, 0, 0, 0); co = __builtin_amdgcn_mfma_f32_16x16x32_bf16(a0, Sb[0], co, 0, 0, 0);
                    as = __builtin_amdgcn_mfma_f32_16x16x32_bf16(b1, Sb[1], as, 0, 0, 0); co = __builtin_amdgcn_mfma_f32_16x16x32_bf16(a1, Sb[1], co, 0, 0, 0);
                    S[mt] = as;
                    f32x4 sqv = co * co;
#pragma unroll
                    for (int i = 0; i < 4; ++i) { ot[(16 * mt + 4 * q + i) * 68 + crow_] = co[i];
                        float v = sqv[i]; v += __shfl_xor(v, 1); v += __shfl_xor(v, 2); v += __shfl_xor(v, 4); v += __shfl_xor(v, 8); sqv[i] = v; }
                    if (r16 == 0) *(LAS f32x4*)(xb + 16 * mt + 4 * q) = sqv;
                }
            }
            __syncthreads();
        }
        float* so = A.out + (prompt ? O_GP + ((size_t)(l * BATCH + b) * BH + h) * 4096 : O_GS + ((size_t)(l * DECB + b) * BH + h) * 4096) + 16 * w4 + r16;
#pragma unroll
        for (int mt = 0; mt < 4; ++mt)
#pragma unroll
            for (int i = 0; i < 4; ++i) so[(16 * mt + 4 * q + i) * 64] = S[mt][i];
    } else {
        const int lt = F.tid - 256;
        const int orow_ = lt >> 2, ocw = lt & 3;
        float nw[16];
#pragma unroll
        for (int j = 0; j < 16; ++j) nw[j] = A.in[I_GNW][l * 64 + 16 * ocw + j];
        bf16* obase = (bf16*)(ws + WS_OAB) + rowbase * 1024 + 512 + h * 64 + 16 * ocw;
        v4u ld[8]; v4u zc[2], zn[2]; float ev = 0.f;
        for (int t = -3; t <= nch; ++t) {
            const int sw = t + 2;
            if (sw >= 0 && sw < nch) {
                LAS unsigned char* st = L0 + (sw % NST) * ST_BYTES;
#pragma unroll
                for (int k = 0; k < 8; ++k) { const int id = lt + 256 * k, mat = id >> 9, wi = id & 511; *(LAS v4u*)(st + mat * 8192 + swz(wi >> 3, wi & 7)) = ld[k]; }
                if (lt == 0) ((LAS float*)(L0 + EV_OFF))[sw % NST] = ev;
            }
            const int sl = t + 3;
            if (sl >= 0 && sl < nch) {
                const int uid = uid0 + sl;
#pragma unroll
                for (int k = 0; k < 8; ++k) { const int id = lt + 256 * k, mat = id >> 9, wi = id & 511;
                    ld[k] = *(const GAS v4u*)(ws + (mat == 0 ? WS_GBS : mat == 1 ? WS_GAO : mat == 2 ? WS_GCS : WS_GCO) + (size_t)uid * 8192 + wi * 16); }
                if (lt == 0) ev = ((const float*)(ws + WS_GE))[uid];
            }
            zc[0] = zn[0]; zc[1] = zn[1];
            if (t >= 0 && t < nch && orow_ < nrows) { const bf16* zp = obase + (size_t)(64 * t + orow_) * 1024; zn[0] = *(const GAS v4u*)zp; zn[1] = *(const GAS v4u*)(zp + 8); }
            const int so_ = t - 1;
            if (so_ >= 0 && so_ < nch && orow_ < nrows) {
                const LAS float* ot = (const LAS float*)(L0 + OT_OFF + (so_ & 1) * OT_BYTES) + orow_ * 68 + 16 * ocw; const LAS float* xb = (const LAS float*)(L0 + XB_OFF) + (so_ & 1) * 256 + orow_;
                const float tot = xb[0] + xb[64] + xb[128] + xb[192], rs = 1.0f / sqrtf(tot * (1.f / 64.f) + NORM_EPS);
                float ov[16];
#pragma unroll
                for (int j4 = 0; j4 < 4; ++j4) { const f32x4 o4 = *(const LAS f32x4*)(ot + 4 * j4); ov[4 * j4] = o4[0]; ov[4 * j4 + 1] = o4[1]; ov[4 * j4 + 2] = o4[2]; ov[4 * j4 + 3] = o4[3]; }
                v4u w0, w1;
#pragma unroll
                for (int j = 0; j < 4; ++j) {
                    w0[j] = cvtpk(ov[2 * j] * rs * nw[2 * j] * __uint_as_float(zc[0][j] << 16), ov[2 * j + 1] * rs * nw[2 * j + 1] * __uint_as_float(zc[0][j] & 0xffff0000u));
                    w1[j] = cvtpk(ov[8 + 2 * j] * rs * nw[8 + 2 * j] * __uint_as_float(zc[1][j] << 16), ov[8 + 2 * j + 1] * rs * nw[8 + 2 * j + 1] * __uint_as_float(zc[1][j] & 0xffff0000u)); }
                bf16* op = obase + (size_t)(64 * so_ + orow_) * 1024; *(GAS v4u*)op = w0; *(GAS v4u*)(op + 8) = w1;
            }
            __syncthreads();
        }
    }
}
DI void p_gdn_scan(Frame& F, const CAS Args& A, int l, bool dummy = false) {
    (void)dummy;
    if (F.vcu < BATCH * BH) { gdn_scan_seq(F, A, l, true, F.vcu); return; }
    for (int s = F.vcu - BATCH * BH; s < DECB * BH; s += F.G - BATCH * BH) { gdn_scan_seq(F, A, l, false, s); __syncthreads(); }
}
DI void p_inproj(Frame& F, const CAS Args& A, int l) {
    unsigned char* ws = A.ws;
    pg8::Gemm g{(const pg8::bf16_t*)(ws + WS_HB), (const pg8::bf16_t*)(ws + WS_WIN) + (size_t)l * NIN * D, M, NIN, D};
    pg8::StaticOrder S; S.init(M, NIN, F.G, F.bx);
    pg8::EpiInProj E{ws, A.out, A.in[I_ALOG] + l * 8, A.in[I_DTB] + l * 8, l};
    pg8::gemm_phase<pg8::EpiInProj, pg8::StaticOrder, true, true>(F.lds + RING_OFF, g, S, E, F.tid);
}
DI void p_mix(Frame& F, const CAS Args& A, int l) {
    unsigned char* ws = A.ws;
    pg8::Gemm g{(const pg8::bf16_t*)(ws + WS_OAB), (const pg8::bf16_t*)(ws + WS_WAB) + (size_t)l * D * 1024, M, D, 1024};
    pg8::StaticOrder S; S.init(M, D, F.G, F.bx);
    pg8::EpiMix E{ws};
    pg8::gemm_phase<pg8::EpiMix, pg8::StaticOrder, true, true>(F.lds + RING_OFF, g, S, E, F.tid);
}
DI void p_outproj(Frame& F, const CAS Args& A, int l) {
    unsigned char* ws = A.ws;
    pg8::Gemm g{(const pg8::bf16_t*)(ws + WS_MIX), (const pg8::bf16_t*)(ws + WS_WO) + (size_t)l * D * D, M, D, D};
    pg8::StaticOrder S; S.init(M, D, F.G, F.bx);
    pg8::EpiResid E{A.out + O_Y, (float*)(ws + WS_Z)};
    pg8::gemm_phase<pg8::EpiResid, pg8::StaticOrder, true, true>(F.lds + RING_OFF, g, S, E, F.tid);
}
DI void p_ln(Frame& F, const CAS Args& A, int l) {
    unsigned char* ws = A.ws;
    const float* Z = (const float*)(ws + WS_Z); float* H = A.out + O_Y; bf16* HB = (bf16*)(ws + WS_HB);
    const int gw = F.vcu * NWAVES + F.wave, NGW = F.G * NWAVES;
    for (int m = gw; m < M; m += NGW) ln_row(Z + (size_t)m * D, A.in[I_LNG] + (size_t)l * D, A.in[I_LNB] + (size_t)l * D, H + (size_t)m * D, HB + (size_t)m * D, F.lane);
}

#ifndef DUP_MASK
#define DUP_MASK 0
#endif
constexpr int PH_PER_LAYER = 7, N_PHASES = 1 + DEPTH * PH_PER_LAYER;
template <int PMASK> __global__ void __launch_bounds__(NWAVES * 64, 2) trunk_fwd(Args args_) {
    const Args& args = args_;
    extern __shared__ __attribute__((aligned(16))) unsigned char lds[];
    LAS unsigned char* const ldsb = (LAS unsigned char*)lds;
    for (int u = threadIdx.x; u < (BIAS_OFF - LDSCTL_OFF) / 4; u += NWAVES * 64) ((LAS unsigned*)(ldsb + LDSCTL_OFF))[u] = 0u;
    __syncthreads();
    const int lo = args.ph_lo, hi = args.ph_hi;
    const int wave_s = __builtin_amdgcn_readfirstlane(threadIdx.x >> 6);
    if (hi - lo > 1) (void)xcd_barrier_post((unsigned*)((gu32*)(args.ws + WS_CTL) + CW_BAR), (volatile LAS unsigned*)(ldsb + MISC_OFF) + 8);
#define PH_BEGIN(k) if (lo <= (k) && (k) < hi) { \
        const CAS Args* kp = (const CAS Args*)__builtin_amdgcn_kernarg_segment_ptr(); asm volatile("" : "+s"(kp)); const CAS Args& A_ = *kp; \
        int tid = wave_s * 64 + (int)__builtin_amdgcn_mbcnt_hi(~0u, __builtin_amdgcn_mbcnt_lo(~0u, 0u)), bx = blockIdx.x; asm volatile("" : "+v"(tid)); asm volatile("" : "+s"(bx)); \
        Frame F; F.lds = ldsb; F.MISC = (volatile LAS unsigned*)(ldsb + MISC_OFF); F.tid = tid; F.lane = tid & 63; F.wave = __builtin_amdgcn_readfirstlane(tid >> 6); \
        F.G = gridDim.x; F.vcu = (F.G % 8 == 0) ? (bx % 8) * (F.G / 8) + bx / 8 : bx; F.bx = bx; F.ctl = (gu32*)(A_.ws + WS_CTL);
#define PH_END(k) if ((k) + 1 < hi) { XcdBarrier bar; bar.bar = (unsigned*)((gu32*)(A_.ws + WS_CTL) + CW_BAR); bar.x = xb_xcc_id(); bar.st = (volatile LAS unsigned*)(ldsb + MISC_OFF) + 8; xcd_barrier(bar, F.tid == 0); } }
#define RUN_LAYER(l) \
    PH_BEGIN(1 + 7 * (l) + 0) if constexpr ((PMASK & 2) != 0) { p_inproj(F, A_, (l)); if (DUP_MASK & 2) { XcdBarrier bar2; bar2.bar = (unsigned*)((gu32*)(A_.ws + WS_CTL) + CW_BAR); bar2.x = xb_xcc_id(); bar2.st = (volatile LAS unsigned*)(ldsb + MISC_OFF) + 8; xcd_barrier(bar2, F.tid == 0); p_inproj(F, A_, (l)); } } PH_END(1 + 7 * (l) + 0) \
    PH_BEGIN(1 + 7 * (l) + 1) if constexpr ((PMASK & 4) != 0) { if (DUP_MASK & 4) { p_attention(F, A_, (l), true); __syncthreads(); } p_conv(F, A_, (l)); p_attention(F, A_, (l)); } PH_END(1 + 7 * (l) + 1) \
    PH_BEGIN(1 + 7 * (l) + 2) if constexpr ((PMASK & 8) != 0) { p_gdn_prep(F, A_, (l)); if (DUP_MASK & 8) { __syncthreads(); p_gdn_prep(F, A_, (l)); } } PH_END(1 + 7 * (l) + 2) \
    PH_BEGIN(1 + 7 * (l) + 3) if constexpr ((PMASK & 16) != 0) { if (DUP_MASK & 16) { p_gdn_scan(F, A_, (l), true); __syncthreads(); } p_gdn_scan(F, A_, (l)); } PH_END(1 + 7 * (l) + 3) \
    PH_BEGIN(1 + 7 * (l) + 4) if constexpr ((PMASK & 32) != 0) { p_mix(F, A_, (l)); if (DUP_MASK & 32) { __syncthreads(); p_mix(F, A_, (l)); } } PH_END(1 + 7 * (l) + 4) \
    PH_BEGIN(1 + 7 * (l) + 5) if constexpr ((PMASK & 64) != 0) { p_outproj(F, A_, (l)); if (DUP_MASK & 64) { __syncthreads(); p_outproj(F, A_, (l)); } } PH_END(1 + 7 * (l) + 5) \
    PH_BEGIN(1 + 7 * (l) + 6) if constexpr ((PMASK & 128) != 0) { p_ln(F, A_, (l)); if (DUP_MASK & 128) { __syncthreads(); p_ln(F, A_, (l)); } } PH_END(1 + 7 * (l) + 6)
    PH_BEGIN(0) if constexpr ((PMASK & 1) != 0) { p0_prologue(F, A_); if (DUP_MASK & 1) { __syncthreads(); p0_prologue(F, A_); } } PH_END(0)
    RUN_LAYER(0)
    RUN_LAYER(1)
#undef PH_BEGIN
#undef PH_END
#undef RUN_LAYER
}

extern "C" void kernel_launch(void* const* d_in, const int* in_sizes, int n_in, void* d_out, int out_size, void* d_ws, size_t ws_size, hipStream_t stream) {
    static int grid = 0;
    if (grid == 0) {
        if (n_in != 19 || in_sizes[0] != MP * D || (size_t)out_size != O_END || ws_size < WS_END) {
            fprintf(stderr, "kernel_launch: unexpected shapes: n_in %d in0 %d out %d ws %zu (need %zu); nothing launched\n", n_in, n_in > 0 ? in_sizes[0] : -1, out_size, ws_size, (size_t)WS_END); grid = -1; return; }
        int dev = 0, cus = 0, per_cu = 0;
        if (hipGetDevice(&dev) != hipSuccess || hipDeviceGetAttribute(&cus, hipDeviceAttributeMultiprocessorCount, dev) != hipSuccess) { grid = -1; return; }
        bool okattr = true;
#define SETATTR(MK) okattr = okattr && (hipFuncSetAttribute((const void*)trunk_fwd<MK>, hipFuncAttributeMaxDynamicSharedMemorySize, LDS_BYTES) == hipSuccess)
#if MK_PER_PHASE
        SETATTR(1); SETATTR(2); SETATTR(4); SETATTR(8); SETATTR(16); SETATTR(32); SETATTR(64); SETATTR(128);
#else
        SETATTR(0xff);
#endif
        if (!okattr) { fprintf(stderr, "kernel_launch: hipFuncSetAttribute failed\n"); grid = -1; return; }
        (void)per_cu; (void)hipGetLastError();
        grid = cus;
    }
    if (grid < 0) return;
    if (hipMemsetAsync((char*)d_ws + WS_CTL, 0, CTL_ZERO_BYTES, stream) != hipSuccess) return;
    Args a{};
    for (int i = 0; i < 19; ++i) a.in[i] = (const float*)d_in[i];
    a.out = (float*)d_out; a.ws = (unsigned char*)d_ws;
#if MK_PER_PHASE
    for (int ph = 0; ph < N_PHASES; ++ph) {
        const int s = ph == 0 ? -1 : (ph - 1) % PH_PER_LAYER;
        a.ph_lo = ph; a.ph_hi = ph + 1; a.li = 0;
        const dim3 g(grid), b(NWAVES * 64);
        if (s == -1) hipLaunchKernelGGL(trunk_fwd<1>, g, b, LDS_BYTES, stream, a);
        else if (s == 0) hipLaunchKernelGGL(trunk_fwd<2>, g, b, LDS_BYTES, stream, a);
        else if (s == 1) hipLaunchKernelGGL(trunk_fwd<4>, g, b, LDS_BYTES, stream, a);
        else if (s == 2) hipLaunchKernelGGL(trunk_fwd<8>, g, b, LDS_BYTES, stream, a);
        else if (s == 3) hipLaunchKernelGGL(trunk_fwd<16>, g, b, LDS_BYTES, stream, a);
        else if (s == 4) hipLaunchKernelGGL(trunk_fwd<32>, g, b, LDS_BYTES, stream, a);
        else if (s == 5) hipLaunchKernelGGL(trunk_fwd<64>, g, b, LDS_BYTES, stream, a);
        else hipLaunchKernelGGL(trunk_fwd<128>, g, b, LDS_BYTES, stream, a);
    }
#else
    a.ph_lo = 0; a.ph_hi = N_PHASES; a.li = 0;
    hipLaunchKernelGGL(trunk_fwd<0xff>, dim3(grid), dim3(NWAVES * 64), LDS_BYTES, stream, a);
#endif
}
```
